# Optimizing an MI355X kernel written in HIP

```python
import math
import jax, jax.numpy as jnp
from jax import lax
import numpy as np

D_MODEL = 1024
BATCH = 4
SEQ = 4096
DEPTH = 1

N_HEADS = 8
QK_NOPE_DIM = 64
QK_ROPE_DIM = 32
V_HEAD_DIM = 64
Q_LORA_RANK = 384
KV_LORA_RANK = 256
ROPE_THETA = 10000.0
Q_BLOCK = 128
SSM_CHANNELS = D_MODEL // 2
SSM_GROUP = 16
SSM_GROUPS = SSM_CHANNELS // SSM_GROUP
SSM_STATE = 64
SSM_DIRS = 2
DT_MIN = 1e-3
DT_MAX = 1e-1
FFN_HIDDEN = ((8 * D_MODEL // 3 + 255) // 256) * 256
N_BRANCHES = 2
EPS = 1e-6
SPLITS = [Q_LORA_RANK, Q_LORA_RANK + KV_LORA_RANK, Q_LORA_RANK + KV_LORA_RANK + QK_ROPE_DIM, Q_LORA_RANK + KV_LORA_RANK + QK_ROPE_DIM + SSM_CHANNELS]
IN_COLS = Q_LORA_RANK + KV_LORA_RANK + QK_ROPE_DIM + SSM_CHANNELS + N_BRANCHES * D_MODEL

kernel_name = 'hybrid_mla_s5_sandwich_adaln_block'


def _rms(x, g):
    x32 = x.astype(jnp.float32)
    y = x32 * lax.rsqrt(jnp.mean(x32 * x32, axis=-1, keepdims=True) + EPS) * g.astype(jnp.float32)
    return y.astype(x.dtype)


def _rope_tables(positions):
    inv_freq = ROPE_THETA ** (-jnp.arange(0, QK_ROPE_DIM, 2, dtype=jnp.float32) / QK_ROPE_DIM)
    ang = positions.astype(jnp.float32)[..., None] * inv_freq
    return jnp.cos(ang), jnp.sin(ang)


def _apply_rope(x, cos, sin):
    x32 = x.astype(jnp.float32)
    x1, x2 = jnp.split(x32, 2, axis=-1)
    return jnp.concatenate([x1 * cos - x2 * sin, x2 * cos + x1 * sin], axis=-1).astype(x.dtype)


def _mla(q_lat, kv_lat, k_rope_raw, positions, g_qn, g_kvn, w_uq, w_uk, w_uv, w_o):
    bsz, s, _ = q_lat.shape
    q = (_rms(q_lat, g_qn) @ w_uq).reshape(bsz, s, N_HEADS, QK_NOPE_DIM + QK_ROPE_DIM)
    q_nope, q_rope = q[..., :QK_NOPE_DIM], q[..., QK_NOPE_DIM:]
    kv = _rms(kv_lat, g_kvn)
    k_nope = (kv @ w_uk).reshape(bsz, s, N_HEADS, QK_NOPE_DIM)
    v = (kv @ w_uv).reshape(bsz, s, N_HEADS, V_HEAD_DIM)
    cos, sin = _rope_tables(positions)
    q_rope = _apply_rope(q_rope, cos[:, :, None, :], sin[:, :, None, :])
    k_rope = _apply_rope(k_rope_raw, cos, sin)
    scale = (QK_NOPE_DIM + QK_ROPE_DIM) ** -0.5
    nb = s // Q_BLOCK
    qn_b = (q_nope * scale).reshape(bsz, nb, Q_BLOCK, N_HEADS, QK_NOPE_DIM).transpose(1, 0, 2, 3, 4)
    qr_b = (q_rope * scale).reshape(bsz, nb, Q_BLOCK, N_HEADS, QK_ROPE_DIM).transpose(1, 0, 2, 3, 4)

    def block(args):
        qn, qr = args
        sc = jnp.einsum('bqhd,bkhd->bhqk', qn, k_nope) + jnp.einsum('bqhr,bkr->bhqk', qr, k_rope)
        p = jax.nn.softmax(sc.astype(jnp.float32), axis=-1).astype(v.dtype)
        return jnp.einsum('bhqk,bkhd->bqhd', p, v)

    o = lax.map(block, (qn_b, qr_b))
    o = o.transpose(1, 0, 2, 3, 4).reshape(bsz, s, N_HEADS * V_HEAD_DIM)
    return o @ w_o


def _scan_combine(left, right):
    ar1, ai1, br1, bi1 = left
    ar2, ai2, br2, bi2 = right
    return (ar2 * ar1 - ai2 * ai1,
            ar2 * ai1 + ai2 * ar1,
            ar2 * br1 - ai2 * bi1 + br2,
            ar2 * bi1 + ai2 * br1 + bi2)


def _s5_direction(u, lam_re, lam_im, log_dt, b_re, b_im, c_re, c_im, reverse):
    s = u.shape[1]
    lam_re = jnp.minimum(lam_re.astype(jnp.float32), -1e-4)
    lam_im = lam_im.astype(jnp.float32)
    dt = jnp.exp(log_dt.astype(jnp.float32))[:, None]
    mag = jnp.exp(lam_re * dt)
    ab_re = mag * jnp.cos(lam_im * dt)
    ab_im = mag * jnp.sin(lam_im * dt)
    nr, ni = ab_re - 1.0, ab_im
    den = lam_re * lam_re + lam_im * lam_im
    f_re = (nr * lam_re + ni * lam_im) / den
    f_im = (ni * lam_re - nr * lam_im) / den
    b_re = b_re.astype(jnp.float32)
    b_im = b_im.astype(jnp.float32)
    bb_re = f_re[..., None] * b_re - f_im[..., None] * b_im
    bb_im = f_re[..., None] * b_im + f_im[..., None] * b_re
    xr = jnp.einsum('bsgh,gph->bsgp', u, bb_re)
    xi = jnp.einsum('bsgh,gph->bsgp', u, bb_im)
    a_re = jnp.broadcast_to(ab_re[None, None], (1, s) + ab_re.shape)
    a_im = jnp.broadcast_to(ab_im[None, None], (1, s) + ab_im.shape)
    _, _, hr, hi = lax.associative_scan(_scan_combine, (a_re, a_im, xr, xi), reverse=reverse, axis=1)
    return (jnp.einsum('bsgp,ghp->bsgh', hr, c_re.astype(jnp.float32))
            - jnp.einsum('bsgp,ghp->bsgh', hi, c_im.astype(jnp.float32)))


def _s5_branch(u, lam_re, lam_im, log_dt, b_re, b_im, c_re, c_im, d_skip, w_glu):
    bsz, s, _ = u.shape
    ug = u.astype(jnp.float32).reshape(bsz, s, SSM_GROUPS, SSM_GROUP)
    y = (_s5_direction(ug, lam_re[0], lam_im[0], log_dt[0], b_re[0], b_im[0], c_re[0], c_im[0], False)
         + _s5_direction(ug, lam_re[1], lam_im[1], log_dt[1], b_re[1], b_im[1], c_re[1], c_im[1], True))
    y = y.reshape(bsz, s, SSM_CHANNELS) + d_skip.astype(jnp.float32) * u.astype(jnp.float32)
    y = jax.nn.gelu(y).astype(u.dtype)
    a, g = jnp.split(y @ w_glu, 2, axis=-1)
    return a * jax.nn.sigmoid(g)


def setup_inputs(seed: int = 0) -> dict:
    key = jax.random.key(seed)
    ks = jax.random.split(key, 32)
    f32 = jnp.float32
    L, D, H = DEPTH, D_MODEL, N_HEADS
    G, P, C = SSM_GROUPS, SSM_STATE, SSM_GROUP

    def nrm(k, shape, fan_in, mult=1.0):
        return jax.random.normal(k, shape, f32) * (mult * fan_in ** -0.5)

    def gain(k, shape):
        return 1.0 + 0.01 * jax.random.normal(k, shape, f32)

    x = jax.random.normal(ks[0], (BATCH, SEQ, D), f32)
    c = jax.random.normal(ks[1], (BATCH, D), f32)
    positions = (jnp.arange(SEQ, dtype=jnp.int32)[None, :]
                 + jax.random.randint(ks[2], (BATCH, 1), 0, 2048, dtype=jnp.int32))
    n_idx = jnp.arange(P, dtype=f32)
    lam_re = -0.5 + 1e-3 * jax.random.normal(ks[3], (L, SSM_DIRS, G, P), f32)
    lam_im = math.pi * n_idx + 1e-3 * jax.random.normal(ks[4], (L, SSM_DIRS, G, P), f32)
    log_dt = jax.random.uniform(ks[5], (L, SSM_DIRS, G), f32, math.log(DT_MIN), math.log(DT_MAX))
    return {
        'x': x,
        'c': c,
        'positions': positions,
        'w_ada': nrm(ks[6], (L, D, 6 * D), D, 0.5),
        'b_ada': 0.01 * jax.random.normal(ks[7], (L, 6 * D), f32),
        'g_pre_mix': gain(ks[8], (L, D)),
        'g_post_mix': gain(ks[9], (L, D)),
        'g_pre_ffn': gain(ks[10], (L, D)),
        'g_post_ffn': gain(ks[11], (L, D)),
        'w_in': nrm(ks[12], (L, D, IN_COLS), D),
        'g_q_norm': gain(ks[13], (L, Q_LORA_RANK)),
        'g_kv_norm': gain(ks[14], (L, KV_LORA_RANK)),
        'w_uq': nrm(ks[15], (L, Q_LORA_RANK, H * (QK_NOPE_DIM + QK_ROPE_DIM)), Q_LORA_RANK),
        'w_uk': nrm(ks[16], (L, KV_LORA_RANK, H * QK_NOPE_DIM), KV_LORA_RANK),
        'w_uv': nrm(ks[17], (L, KV_LORA_RANK, H * V_HEAD_DIM), KV_LORA_RANK),
        'w_attn_out': nrm(ks[18], (L, H * V_HEAD_DIM, D), H * V_HEAD_DIM),
        'ssm_lambda_re': lam_re,
        'ssm_lambda_im': lam_im,
        'ssm_log_dt': log_dt,
        'ssm_b_re': nrm(ks[19], (L, SSM_DIRS, G, P, C), 2 * C),
        'ssm_b_im': nrm(ks[20], (L, SSM_DIRS, G, P, C), 2 * C),
        'ssm_c_re': nrm(ks[21], (L, SSM_DIRS, G, C, P), 2 * P),
        'ssm_c_im': nrm(ks[22], (L, SSM_DIRS, G, C, P), 2 * P),
        'ssm_d': jax.random.normal(ks[23], (L, SSM_CHANNELS), f32),
        'w_glu': nrm(ks[24], (L, SSM_CHANNELS, 2 * D), SSM_CHANNELS),
        'w_mix_out': nrm(ks[25], (L, D, D), D),
        'w_ffn_in': nrm(ks[26], (L, D, 2 * FFN_HIDDEN), D),
        'w_ffn_out': nrm(ks[27], (L, FFN_HIDDEN, D), FFN_HIDDEN),
    }


def reference(x, c, positions, w_ada, b_ada, g_pre_mix, g_post_mix, g_pre_ffn, g_post_ffn,
              w_in, g_q_norm, g_kv_norm, w_uq, w_uk, w_uv, w_attn_out,
              ssm_lambda_re, ssm_lambda_im, ssm_log_dt, ssm_b_re, ssm_b_im, ssm_c_re, ssm_c_im,
              ssm_d, w_glu, w_mix_out, w_ffn_in, w_ffn_out):
    for l in range(DEPTH):
        ada = jax.nn.silu(c) @ w_ada[l] + b_ada[l]
        sh1, sc1, gt1, sh2, sc2, gt2 = jnp.split(ada[:, None, :], 6, axis=-1)
        h = _rms(x, g_pre_mix[l]) * (1.0 + sc1) + sh1
        proj = h @ w_in[l]
        q_lat, kv_lat, k_rope_raw, u, gate_cols = jnp.split(proj, SPLITS, axis=-1)
        branch_a = _mla(q_lat, kv_lat, k_rope_raw, positions, g_q_norm[l], g_kv_norm[l],
                        w_uq[l], w_uk[l], w_uv[l], w_attn_out[l])
        branch_b = _s5_branch(u, ssm_lambda_re[l], ssm_lambda_im[l], ssm_log_dt[l],
                              ssm_b_re[l], ssm_b_im[l], ssm_c_re[l], ssm_c_im[l],
                              ssm_d[l], w_glu[l])
        gate_a, gate_b = jnp.split(jax.nn.sigmoid(gate_cols), N_BRANCHES, axis=-1)
        mixed = (gate_a * branch_a + gate_b * branch_b) @ w_mix_out[l]
        x = x + gt1 * _rms(mixed, g_post_mix[l])
        h = _rms(x, g_pre_ffn[l]) * (1.0 + sc2) + sh2
        g, up = jnp.split(h @ w_ffn_in[l], 2, axis=-1)
        f = (jax.nn.silu(g) * up) @ w_ffn_out[l]
        x = x + gt2 * _rms(f, g_post_ffn[l])
    return x
```

```cpp
#include <hip/hip_runtime.h>
#include <hip/hip_cooperative_groups.h>
#include <cstdio>
#include <cstdint>
namespace cg = cooperative_groups;

#ifndef ATT_NQ
#define ATT_NQ 2
#endif
#ifndef COOP
#define COOP 1
#endif

#define DI __device__ __forceinline__
typedef unsigned short bf16_t;
typedef short bf16x8 __attribute__((ext_vector_type(8)));
typedef float f32x16 __attribute__((ext_vector_type(16)));
typedef __bf16 bf16x2_t __attribute__((ext_vector_type(2)));
typedef float f32x2_t __attribute__((ext_vector_type(2)));
typedef unsigned u32x4 __attribute__((ext_vector_type(4)));
#define MFMA(a, b, c) __builtin_amdgcn_mfma_f32_32x32x16_bf16((a), (b), (c), 0, 0, 0)

constexpr int T = 16384, D = 1024, SEQ = 4096;
constexpr int NPHASE = 13;
constexpr int NTHR = 512, NWAVE = 8;
constexpr size_t MiB = 1u << 20;
constexpr size_t OFF_WIN = 0;
constexpr size_t OFF_WUQ = OFF_WIN + (size_t)3328 * 1024 * 2;
constexpr size_t OFF_WUKV = OFF_WUQ + (size_t)768 * 384 * 2;
constexpr size_t OFF_WO = OFF_WUKV + (size_t)1024 * 256 * 2;
constexpr size_t OFF_WGLU = OFF_WO + (size_t)1024 * 512 * 2;
constexpr size_t OFF_WMIX = OFF_WGLU + (size_t)2048 * 512 * 2;
constexpr size_t OFF_WFI = OFF_WMIX + (size_t)1024 * 1024 * 2;
constexpr size_t OFF_WFO = OFF_WFI + (size_t)5632 * 1024 * 2;
constexpr size_t OFF_ADA = 30 * MiB;
constexpr size_t OFF_SSQ = OFF_ADA + 98304;
constexpr size_t OFF_SSKV = OFF_SSQ + 65536;
constexpr size_t OFF_SSM = OFF_SSKV + 65536;
constexpr size_t OFF_SSF = OFF_SSM + 65536;
constexpr size_t OFF_SA = OFF_SSF + 65536;
constexpr size_t OFF_SAL = OFF_SA + 32768;
constexpr size_t OFF_BBT = OFF_SAL + 32768;
constexpr size_t OFF_CMT = OFF_BBT + 262144;
constexpr size_t OFF_BAR = 31 * MiB;
constexpr size_t OFF_E = 32 * MiB;
constexpr size_t OFF_KROPE = 40 * MiB;
constexpr size_t OFF_H = 41 * MiB;
constexpr size_t OFF_YG = 41 * MiB;
constexpr size_t OFF_O = 57 * MiB;
constexpr size_t OFF_GATES = 73 * MiB;
constexpr size_t OFF_U = 137 * MiB;
constexpr size_t OFF_QLAT = 153 * MiB;
constexpr size_t OFF_KVLAT = 165 * MiB;
constexpr size_t OFF_Q = 173 * MiB;
constexpr size_t OFF_KN = 197 * MiB;
constexpr size_t OFF_VT = 213 * MiB;
constexpr size_t OFF_S = 237 * MiB;
constexpr size_t OFF_BB = 137 * MiB;
constexpr size_t OFF_M = 173 * MiB;
constexpr size_t OFF_MIXED = 205 * MiB;
constexpr size_t OFF_ACT = 73 * MiB;
constexpr size_t OFF_F = 41 * MiB;

constexpr int LDS_BYTES = 135168 + 16;
constexpr int XS_BYTES = 256 * 128;
constexpr int STAGE_BYTES = 2 * XS_BYTES;
constexpr int S5_WAVE_LDS = 16896;

struct Params {
  const float* x; const float* c; const int* pos; const float* w_ada; const float* b_ada;
  const float* g_pre_mix; const float* g_post_mix; const float* g_pre_ffn; const float* g_post_ffn;
  const float* w_in; const float* g_q; const float* g_kv; const float* w_uq; const float* w_uk; const float* w_uv; const float* w_o;
  const float* lam_re; const float* lam_im; const float* log_dt; const float* b_re; const float* b_im; const float* c_re; const float* c_im; const float* ssm_d;
  const float* w_glu; const float* w_mix; const float* w_ffn_in; const float* w_ffn_out;
  float* out; char* ws;
  int phase_begin; int phase_end;
};

typedef const Params __attribute__((address_space(4)))* KP;
DI KP get_kp() { KP k = (KP)__builtin_amdgcn_kernarg_segment_ptr(); asm volatile("" : "+s"(k)); return k; }
DI int otid() { int t = threadIdx.x; asm volatile("" : "+v"(t)); return t; }
DI char* ows(KP p) { char* w = p->ws; asm volatile("" : "+s"(w)); return w; }
DI unsigned pack2(float a, float b) {
  f32x2_t v = {a, b};
  bf16x2_t r = __builtin_convertvector(v, bf16x2_t);
  return __builtin_bit_cast(unsigned, r);
}
DI bf16_t f2bf(float a) { return (bf16_t)(pack2(a, 0.f) & 0xffffu); }
DI float bf2f(unsigned v) { return __uint_as_float(v << 16); }
DI float bflo(unsigned v) { return __uint_as_float(v << 16); }
DI float bfhi(unsigned v) { return __uint_as_float(v & 0xffff0000u); }
DI float sigm(float x) { return __builtin_amdgcn_rcpf(1.f + __expf(-x)); }
DI int crow(int i, int hh) { return (i & 3) + 8 * (i >> 2) + 4 * hh; }
DI float gelu_tanh(float x) {
  float z = 0.7978845608028654f * (x + 0.044715f * x * x * x);
  float t = __expf(2.f * z);
  float th = 1.f - 2.f * __builtin_amdgcn_rcpf(t + 1.f);
  return 0.5f * x * (1.f + th);
}


#define XB_TMO      128
#define XB_XCNT(j)  (256  + 64 * (j))
#define XB_XSUB(j)  (1280 + 64 * (j))
#define XB_XGEN(j)  (2304 + 64 * (j))
#define XB_TOP      3328
#define XB_TOPGEN   3392
#define XCD_BAR_WORDS 3456
#define XB_SPIN_CAP (1u << 20)
#define LAS __attribute__((address_space(3)))
DI unsigned xb_ld(unsigned* p) { return __hip_atomic_load(p, __ATOMIC_RELAXED, __HIP_MEMORY_SCOPE_AGENT); }
DI unsigned xb_add(unsigned* p, unsigned v) { return __hip_atomic_fetch_add(p, v, __ATOMIC_RELAXED, __HIP_MEMORY_SCOPE_AGENT); }
DI unsigned xb_xcc_id() { return (unsigned)__builtin_amdgcn_s_getreg((3 << 11) | 20) & 0xFu; }
#define XB_SPIN(cond, bar) do { unsigned _sp = 0; while (cond) { __builtin_amdgcn_s_sleep(1); \
    if ((++_sp & 255u) == 0u) { if (xb_ld(&(bar)[XB_TMO])) break; if (_sp > XB_SPIN_CAP) { atomicAdd(&(bar)[XB_TMO], 1u); break; } } } } while (0)
struct XcdBarrier { unsigned* bar; unsigned x; volatile LAS unsigned* st; };
DI XcdBarrier xcd_barrier_post(unsigned* bar, volatile LAS unsigned* st) {
  XcdBarrier b; b.bar = bar; b.x = xb_xcc_id(); b.st = st;
  if (threadIdx.x == 0) (void)xb_add(&bar[XB_XCNT(b.x)], 1u);
  return b;
}
DI void xcd_barrier_complete(unsigned* bar, unsigned x, unsigned& nloc, unsigned& nx) {
  const unsigned G = gridDim.x * gridDim.y * gridDim.z;
  unsigned sum, cnt, mine, sp = 0u;
  for (;;) {
    sum = 0u; cnt = 0u; mine = 0u;
#pragma unroll
    for (unsigned j = 0; j < 16; ++j) { const unsigned c = xb_ld(&bar[XB_XCNT(j)]); sum += c; cnt += (c > 0u) ? 1u : 0u; mine = (j == x) ? c : mine; }
    if (sum == G) break;
    __builtin_amdgcn_s_sleep(1);
    if ((++sp & 255u) == 0u) { if (xb_ld(&bar[XB_TMO])) break; if (sp > XB_SPIN_CAP) { atomicAdd(&bar[XB_TMO], 1u); break; } }
  }
  nloc = mine > 0u ? mine : 1u; nx = cnt > 0u ? cnt : 1u;
}
DI void xcd_barrier(const XcdBarrier& b) {
  asm volatile("s_waitcnt vmcnt(0)" ::: "memory");
  __syncthreads();
  if (threadIdx.x == 0) {
    unsigned* bar = b.bar;
    __builtin_amdgcn_s_waitcnt(0);
    unsigned nloc = b.st[0], nx = b.st[1];
    if (nloc == 0u) { xcd_barrier_complete(bar, b.x, nloc, nx); b.st[0] = nloc; b.st[1] = nx; }
    const unsigned old = xb_add(&bar[XB_XSUB(b.x)], 1u);
    const unsigned gen = old / nloc;
    if (old + 1u == (gen + 1u) * nloc) {
      __builtin_amdgcn_fence(__ATOMIC_RELEASE, "agent");
      asm volatile("s_waitcnt vmcnt(0)" ::: "memory");
      const unsigned og = xb_add(&bar[XB_TOP], 1u);
      const unsigned tg = og / nx;
      if (og + 1u == (tg + 1u) * nx) xb_add(&bar[XB_TOPGEN], 1u);
      else XB_SPIN(xb_ld(&bar[XB_TOPGEN]) == tg, bar);
      __builtin_amdgcn_fence(__ATOMIC_ACQUIRE, "agent");
      xb_add(&bar[XB_XGEN(b.x)], 1u);
      asm volatile("s_waitcnt vmcnt(0)" ::: "memory");
    } else {
      XB_SPIN(xb_ld(&bar[XB_XGEN(b.x)]) == gen, bar);
      __builtin_amdgcn_fence(__ATOMIC_ACQUIRE, "agent");
      asm volatile("s_waitcnt vmcnt(0)" ::: "memory");
    }
  }
  __syncthreads();
}

DI void gemm_tile(const bf16_t* __restrict__ X, int ldx, const bf16_t* __restrict__ W, int ldw, int K, f32x16 (&acc)[4][2], char* lds) {
  const int tid = otid(), lane = tid & 63, wave = tid >> 6;
  const int r = lane & 31, hh = lane >> 5, wn = wave & 1, wm = wave >> 1;
#pragma unroll
  for (int ft = 0; ft < 4; ++ft)
#pragma unroll
    for (int tt = 0; tt < 2; ++tt)
#pragma unroll
      for (int i = 0; i < 16; ++i) acc[ft][tt][i] = 0.f;
  const int srow = wave * 32 + (lane >> 3);
  const bf16_t* xg[4]; const bf16_t* wg[4];
#pragma unroll
  for (int i = 0; i < 4; ++i) {
    const int row = srow + i * 8;
    const int ch = (lane & 7) ^ ((row >> 1) & 7);
    xg[i] = X + (size_t)row * ldx + ch * 8;
    wg[i] = W + (size_t)row * ldw + ch * 8;
  }
  char* sdst = lds + wave * 4096;
  const int nk = K >> 6;
#define GLDS_STAGE(st, k0) { _Pragma("unroll") for (int i = 0; i < 4; ++i) { \
    __builtin_amdgcn_global_load_lds((const unsigned*)(xg[i] + (k0)), (__attribute__((address_space(3))) unsigned*)(sdst + (st) * STAGE_BYTES + i * 1024), 16, 0, 0); \
    __builtin_amdgcn_global_load_lds((const unsigned*)(wg[i] + (k0)), (__attribute__((address_space(3))) unsigned*)(sdst + (st) * STAGE_BYTES + XS_BYTES + i * 1024), 16, 0, 0); } }
  GLDS_STAGE(0, 0);
  const int fr = (r >> 1) & 7;
  const int xoff = (wm * 64 + r) * 128, woff = XS_BYTES + (wn * 128 + r) * 128;
  for (int ks = 0; ks < nk; ++ks) {
    asm volatile("s_waitcnt vmcnt(0)" ::: "memory");
    __syncthreads();
    if (ks + 1 < nk) GLDS_STAGE((ks + 1) & 1, (ks + 1) << 6);
    const char* sb = lds + (ks & 1) * STAGE_BYTES;
#pragma unroll
    for (int kk = 0; kk < 4; ++kk) {
      const int po = ((2 * kk + hh) ^ fr) * 16;
      bf16x8 bfr[2], afr[4];
#pragma unroll
      for (int tt = 0; tt < 2; ++tt) bfr[tt] = *(const bf16x8*)(sb + xoff + tt * 4096 + po);
#pragma unroll
      for (int ft = 0; ft < 4; ++ft) afr[ft] = *(const bf16x8*)(sb + woff + ft * 4096 + po);
      __builtin_amdgcn_s_setprio(1);
#pragma unroll
      for (int ft = 0; ft < 4; ++ft)
#pragma unroll
        for (int tt = 0; tt < 2; ++tt) acc[ft][tt] = MFMA(afr[ft], bfr[tt], acc[ft][tt]);
      __builtin_amdgcn_s_setprio(0);
    }
  }
  __syncthreads();
#undef GLDS_STAGE
}

DI void gemm_tile_half(const bf16_t* __restrict__ X, int ldx, const bf16_t* __restrict__ W, int ldw, int K, f32x16 (&acc)[2][2], char* lds) {
  const int tid = otid(), lane = tid & 63, wave = tid >> 6;
  const int r = lane & 31, hh = lane >> 5, wn = wave & 1, wm = wave >> 1;
#pragma unroll
  for (int ft = 0; ft < 2; ++ft)
#pragma unroll
    for (int tt = 0; tt < 2; ++tt)
#pragma unroll
      for (int i = 0; i < 16; ++i) acc[ft][tt][i] = 0.f;
  const int srow = wave * 32 + (lane >> 3);
  const int wrow = wave * 16 + (lane >> 3);
  const bf16_t* xg[4]; const bf16_t* wg[2];
#pragma unroll
  for (int i = 0; i < 4; ++i) { const int row = srow + i * 8; xg[i] = X + (size_t)row * ldx + ((lane & 7) ^ ((row >> 1) & 7)) * 8; }
#pragma unroll
  for (int i = 0; i < 2; ++i) { const int row = wrow + i * 8; wg[i] = W + (size_t)row * ldw + ((lane & 7) ^ ((row >> 1) & 7)) * 8; }
  char* sdx = lds + wave * 4096;
  char* sdw = lds + XS_BYTES + wave * 2048;
  const int nk = K >> 6;
#define GLDS_STAGE_H(st, k0) { _Pragma("unroll") for (int i = 0; i < 4; ++i) \
    __builtin_amdgcn_global_load_lds((const unsigned*)(xg[i] + (k0)), (__attribute__((address_space(3))) unsigned*)(sdx + (st) * STAGE_BYTES + i * 1024), 16, 0, 0); \
    _Pragma("unroll") for (int i = 0; i < 2; ++i) \
    __builtin_amdgcn_global_load_lds((const unsigned*)(wg[i] + (k0)), (__attribute__((address_space(3))) unsigned*)(sdw + (st) * STAGE_BYTES + i * 1024), 16, 0, 0); }
  GLDS_STAGE_H(0, 0);
  const int fr = (r >> 1) & 7;
  const int xoff = (wm * 64 + r) * 128, woff = XS_BYTES + (wn * 64 + r) * 128;
  for (int ks = 0; ks < nk; ++ks) {
    asm volatile("s_waitcnt vmcnt(0)" ::: "memory");
    __syncthreads();
    if (ks + 1 < nk) GLDS_STAGE_H((ks + 1) & 1, (ks + 1) << 6);
    const char* sb = lds + (ks & 1) * STAGE_BYTES;
#pragma unroll
    for (int kk = 0; kk < 4; ++kk) {
      const int po = ((2 * kk + hh) ^ fr) * 16;
      bf16x8 bfr[2], afr[2];
#pragma unroll
      for (int tt = 0; tt < 2; ++tt) bfr[tt] = *(const bf16x8*)(sb + xoff + tt * 4096 + po);
#pragma unroll
      for (int ft = 0; ft < 2; ++ft) afr[ft] = *(const bf16x8*)(sb + woff + ft * 4096 + po);
      __builtin_amdgcn_s_setprio(1);
#pragma unroll
      for (int ft = 0; ft < 2; ++ft)
#pragma unroll
        for (int tt = 0; tt < 2; ++tt) acc[ft][tt] = MFMA(afr[ft], bfr[tt], acc[ft][tt]);
      __builtin_amdgcn_s_setprio(0);
    }
  }
  __syncthreads();
#undef GLDS_STAGE_H
}

typedef float f32x4v __attribute__((ext_vector_type(4)));
DI void stage_rc16(int b, int& R, int& C) {
  const int st = b >> 10, sb = b & 1023, swz = sb ^ (((sb >> 9) & 1) << 5);
  R = (st >> 1) * 16 + (swz >> 6); C = (st & 1) * 32 + ((swz & 63) >> 1);
}
DI void gemm_tile16(const bf16_t* __restrict__ X, int ldx, const bf16_t* __restrict__ W, int ldw, int K, f32x4v (&acc)[8][4], char* lds) {
  const int tid = otid(), lane = tid & 63, wave = tid >> 6;
  const int fr = lane & 15, fq = lane >> 4, wr = wave >> 2, wc = wave & 3;
#pragma unroll
  for (int m = 0; m < 8; ++m)
#pragma unroll
    for (int n = 0; n < 4; ++n) acc[m][n] = (f32x4v){0.f, 0.f, 0.f, 0.f};
  int R0, C0; stage_rc16(wave * 1024 + lane * 16, R0, C0);
  const bf16_t* xg0 = X + (size_t)R0 * ldx + C0;
  const bf16_t* wg0 = W + (size_t)R0 * ldw + C0;
  char* sdst = lds + wave * 1024;
  const int nk = K >> 6;
#define GLDS_STAGE16(st, k0) { _Pragma("unroll") for (int i = 0; i < 4; ++i) { \
    __builtin_amdgcn_global_load_lds((const unsigned*)(xg0 + (size_t)(64 * i) * ldx + (k0)), (__attribute__((address_space(3))) unsigned*)(sdst + (st) * STAGE_BYTES + i * 8192), 16, 0, 0); \
    __builtin_amdgcn_global_load_lds((const unsigned*)(wg0 + (size_t)(64 * i) * ldw + (k0)), (__attribute__((address_space(3))) unsigned*)(sdst + (st) * STAGE_BYTES + XS_BYTES + i * 8192), 16, 0, 0); } }
  GLDS_STAGE16(0, 0);
  const int ob = fr * 64 + fq * 16;
  const int lo = ob ^ (((ob >> 9) & 1) << 5);
  const int xoff = (wc * 4) * 2048 + lo, woff = XS_BYTES + (wr * 8) * 2048 + lo;
  for (int ks = 0; ks < nk; ++ks) {
    asm volatile("s_waitcnt vmcnt(0)" ::: "memory");
    __syncthreads();
    if (ks + 1 < nk) GLDS_STAGE16((ks + 1) & 1, (ks + 1) << 6);
    const char* sb = lds + (ks & 1) * STAGE_BYTES;
#pragma unroll
    for (int k2 = 0; k2 < 2; ++k2) {
      bf16x8 af[8], bf[4];
#pragma unroll
      for (int m = 0; m < 8; ++m) af[m] = *(const bf16x8*)(sb + woff + m * 2048 + k2 * 1024);
#pragma unroll
      for (int n = 0; n < 4; ++n) bf[n] = *(const bf16x8*)(sb + xoff + n * 2048 + k2 * 1024);
      __builtin_amdgcn_s_setprio(1);
#pragma unroll
      for (int m = 0; m < 8; ++m)
#pragma unroll
        for (int n = 0; n < 4; ++n) acc[m][n] = __builtin_amdgcn_mfma_f32_16x16x32_bf16(af[m], bf[n], acc[m][n], 0, 0, 0);
      __builtin_amdgcn_s_setprio(0);
    }
  }
  __syncthreads();
#undef GLDS_STAGE16
}

DI bool tile_coord(int k, int NT, int& tm, int& tn) {
  if (gridDim.x & 7) {
    const int l = blockIdx.x + gridDim.x * k;
    if (l >= 64 * NT) return false;
    tm = l / NT; tn = l - tm * NT;
    return true;
  }
  const int xcd = blockIdx.x & 7, j = blockIdx.x >> 3, nper = gridDim.x >> 3;
  const int l = j + nper * k;
  if (l >= 8 * NT) return false;
  tm = xcd * 8 + (l & 7); tn = l >> 3;
  return true;
}

DI void st4(bf16_t* p, float a, float b, float c, float d) {
  uint2 v; v.x = pack2(a, b); v.y = pack2(c, d);
  *(uint2*)p = v;
}

DI int dest_row(int mode, int n, int Nh) {
  if (mode == 0) return n;
  if (mode == 1) {
    if (n < 640) return n;
    if (n < 672) return 3200 + (n - 640);
    return n - 32;
  }
  const int m = n < Nh ? n : n - Nh;
  if (mode == 3) { const int b16 = (m >> 4) * 32 + (m & 15); return n < Nh ? b16 : b16 + 16; }
  const int base = (m >> 5) * 64 + (m & 31);
  return n < Nh ? base : base + 32;
}

DI void transpose_unit(const float* __restrict__ W, int K, int N, int kt, int nt, bf16_t* __restrict__ out, int mode, int Nh,
                       const float* __restrict__ kscale, float* lds) {
  const int tid = otid();
  const int k0 = kt * 64, n0 = nt * 256;
  const int c4 = tid & 63, rb = tid >> 6;
  float4 v[8];
#pragma unroll
  for (int i = 0; i < 8; ++i) {
    const int k = rb + 8 * i;
    const int n = n0 + c4 * 4;
    v[i] = make_float4(0.f, 0.f, 0.f, 0.f);
    if (n < N) v[i] = *(const float4*)(W + (size_t)(k0 + k) * N + n);
  }
#pragma unroll
  for (int i = 0; i < 8; ++i) {
    const int k = rb + 8 * i;
    if (kscale) { const float sc = kscale[k0 + k]; v[i].x *= sc; v[i].y *= sc; v[i].z *= sc; v[i].w *= sc; }
    *(float4*)(lds + k * 260 + c4 * 4) = v[i];
  }
  __syncthreads();
#pragma unroll
  for (int i = 0; i < 4; ++i) {
    const int id = tid + NTHR * i;
    const int nl = id & 255, c = id >> 8;
    const int n = n0 + nl;
    if (n < N) {
      float t[8];
#pragma unroll
      for (int j = 0; j < 8; ++j) t[j] = lds[(c * 8 + j) * 260 + nl];
      uint4 o; o.x = pack2(t[0], t[1]); o.y = pack2(t[2], t[3]); o.z = pack2(t[4], t[5]); o.w = pack2(t[6], t[7]);
      *(uint4*)(out + (size_t)dest_row(mode, n, Nh) * K + k0 + c * 8) = o;
    }
  }
  __syncthreads();
}

DI void ada_unit(KP p, int j, float* lds) {
  const int tid = otid();
  float* sc = lds;
  float* red = lds + 4096;
  for (int i = tid; i < 4096; i += NTHR) { const float v = p->c[i]; sc[i] = v * sigm(v); }
  __syncthreads();
  const int cg4 = tid & 15, kg = tid >> 4;
  const int n = j * 64 + cg4 * 4;
  float acc[4][4];
#pragma unroll
  for (int b = 0; b < 4; ++b)
#pragma unroll
    for (int c = 0; c < 4; ++c) acc[b][c] = 0.f;
  const float* w = p->w_ada + (size_t)(kg * 32) * 6144 + n;
#pragma unroll 16
  for (int k = 0; k < 32; ++k) {
    const float4 wv = *(const float4*)(w + (size_t)k * 6144);
    const int kk = kg * 32 + k;
#pragma unroll
    for (int b = 0; b < 4; ++b) {
      const float sv = sc[b * 1024 + kk];
      acc[b][0] += sv * wv.x; acc[b][1] += sv * wv.y; acc[b][2] += sv * wv.z; acc[b][3] += sv * wv.w;
    }
  }
#pragma unroll
  for (int b = 0; b < 4; ++b) *(float4*)(red + (kg * 4 + b) * 64 + cg4 * 4) = make_float4(acc[b][0], acc[b][1], acc[b][2], acc[b][3]);
  __syncthreads();
  if (tid < 256) {
    const int b = tid >> 6, col = tid & 63;
    float s = 0.f;
#pragma unroll 8
    for (int g = 0; g < 32; ++g) s += red[(g * 4 + b) * 64 + col];
    float* ada = (float*)(ows(p) + OFF_ADA);
    ada[b * 6144 + j * 64 + col] = s + p->b_ada[j * 64 + col];
  }
  __syncthreads();
}

DI void s5param_unit(KP p, int dg) {
  const int tid = otid();
  const int pi = tid & 63, qtr = tid >> 6;
  const float lr = fminf(p->lam_re[dg * 64 + pi], -1e-4f);
  const float li = p->lam_im[dg * 64 + pi];
  const float dt = expf(p->log_dt[dg]);
  const float mag = expf(lr * dt);
  float sn_, cs_; sincosf(li * dt, &sn_, &cs_);
  const float ar = mag * cs_, ai = mag * sn_;
  const float nr = ar - 1.f, ni = ai;
  const float den = lr * lr + li * li;
  const float fre = (nr * lr + ni * li) / den, fim = (ni * lr - nr * li) / den;
  if (qtr == 0) {
    float2* A = (float2*)(ows(p) + OFF_SA);
    float2* AL = (float2*)(ows(p) + OFF_SAL);
    A[dg * 64 + pi] = make_float2(ar, ai);
    float pr = ar, pim = ai;
#pragma unroll
    for (int s = 0; s < 6; ++s) { const float t = pr * pr - pim * pim; pim = (pr + pr) * pim; pr = t; }
    AL[dg * 64 + pi] = make_float2(pr, pim);
  }
  char* wsl = ows(p);
  bf16_t* BBT = (bf16_t*)(wsl + OFF_BBT);
  bf16_t* CMT = (bf16_t*)(wsl + OFF_CMT);
#pragma unroll
  for (int q = 0; q < 2; ++q) {
    const int ch = qtr * 2 + q;
    const float bre = p->b_re[(size_t)(dg * 64 + pi) * 16 + ch], bim = p->b_im[(size_t)(dg * 64 + pi) * 16 + ch];
    BBT[(size_t)(dg * 128 + pi) * 16 + ch] = f2bf(fre * bre - fim * bim);
    BBT[(size_t)(dg * 128 + 64 + pi) * 16 + ch] = f2bf(fre * bim + fim * bre);
    const float cre = p->c_re[(size_t)(dg * 16 + ch) * 64 + pi], cim = p->c_im[(size_t)(dg * 16 + ch) * 64 + pi];
    CMT[(size_t)(dg * 16 + ch) * 128 + 2 * pi] = f2bf(cre);
    CMT[(size_t)(dg * 16 + ch) * 128 + 2 * pi + 1] = f2bf(-cim);
  }
}

DI float wave_sum(float v) {
#pragma unroll
  for (int o = 32; o >= 1; o >>= 1) v += __shfl_xor(v, o);
  return v;
}

DI void phase0(KP p, char* lds) {
  constexpr int U_WIN = 16 * 13, U_WUQ = 6 * 3, U_WUK = 4 * 2, U_WUV = 4 * 2, U_WO = 8 * 4, U_WGLU = 8 * 8, U_WMIX = 16 * 4, U_WFI = 16 * 22, U_WFO = 44 * 4;
  constexpr int B1 = U_WIN, B2 = B1 + U_WUQ, B3 = B2 + U_WUK, B4 = B3 + U_WUV, B5 = B4 + U_WO, B6 = B5 + U_WGLU, B7 = B6 + U_WMIX, B8 = B7 + U_WFI, B9 = B8 + U_WFO;
  constexpr int B10 = B9 + 96, B11 = B10 + 64, B12 = B11 + 2;
  char* ws = ows(p);
  for (int u0 = blockIdx.x; u0 < B12 - (B9 - B7); u0 += gridDim.x) {
    const int u = u0 < B7 ? u0 : u0 + (B9 - B7);
    if (u < B1) { const int v = u; transpose_unit(p->w_in, 1024, 3232, v / 13, v % 13, (bf16_t*)(ws + OFF_WIN), 1, 0, nullptr, (float*)lds); }
    else if (u < B2) { const int v = u - B1; transpose_unit(p->w_uq, 384, 768, v / 3, v % 3, (bf16_t*)(ws + OFF_WUQ), 0, 0, p->g_q, (float*)lds); }
    else if (u < B3) { const int v = u - B2; transpose_unit(p->w_uk, 256, 512, v / 2, v % 2, (bf16_t*)(ws + OFF_WUKV), 0, 0, p->g_kv, (float*)lds); }
    else if (u < B4) { const int v = u - B3; transpose_unit(p->w_uv, 256, 512, v / 2, v % 2, (bf16_t*)(ws + OFF_WUKV) + (size_t)512 * 256, 0, 0, p->g_kv, (float*)lds); }
    else if (u < B5) { const int v = u - B4; transpose_unit(p->w_o, 512, 1024, v / 4, v % 4, (bf16_t*)(ws + OFF_WO), 0, 0, nullptr, (float*)lds); }
    else if (u < B6) { const int v = u - B5; transpose_unit(p->w_glu, 512, 2048, v / 8, v % 8, (bf16_t*)(ws + OFF_WGLU), 3, 1024, nullptr, (float*)lds); }
    else if (u < B7) { const int v = u - B6; transpose_unit(p->w_mix, 1024, 1024, v / 4, v % 4, (bf16_t*)(ws + OFF_WMIX), 0, 0, nullptr, (float*)lds); }
    else if (u < B8) { const int v = u - B7; transpose_unit(p->w_ffn_in, 1024, 5632, v / 22, v % 22, (bf16_t*)(ws + OFF_WFI), 3, 2816, nullptr, (float*)lds); }
    else if (u < B9) { const int v = u - B8; transpose_unit(p->w_ffn_out, 2816, 1024, v / 4, v % 4, (bf16_t*)(ws + OFF_WFO), 0, 0, nullptr, (float*)lds); }
    else if (u < B10) { ada_unit(p, u - B9, (float*)lds); }
    else if (u < B11) { s5param_unit(p, u - B10); }
    else if (u == B11) {
      float* z = (float*)(ws + OFF_SSQ);
      for (int i = otid(); i < 4 * 16384; i += NTHR) z[i] = 0.f;
    } else {
      uint4* z = (uint4*)(ws + OFF_WIN + (size_t)3232 * 1024 * 2);
      unsigned z0_ = 0u; asm volatile("" : "+v"(z0_));
      const uint4 zz = make_uint4(z0_, z0_, z0_, z0_);
      for (int i = otid(); i < 96 * 1024 * 2 / 16; i += NTHR) z[i] = zz;
    }
  }
}

DI void phase0_deferred(KP p, char* lds, int rank, int stride) {
  constexpr int U_WFI = 16 * 22, U_WFO = 44 * 4;
  char* ws = ows(p);
  for (int v0 = rank; v0 < U_WFI + U_WFO; v0 += stride) {
    if (v0 < U_WFI) { const int v = v0; transpose_unit(p->w_ffn_in, 1024, 5632, v / 22, v % 22, (bf16_t*)(ws + OFF_WFI), 3, 2816, nullptr, (float*)lds); }
    else { const int v = v0 - U_WFI; transpose_unit(p->w_ffn_out, 2816, 1024, v / 4, v % 4, (bf16_t*)(ws + OFF_WFO), 0, 0, nullptr, (float*)lds); }
  }
}

DI void phase1(KP p) {
  const int tid_ = otid(); const int lane = tid_ & 63, wave = tid_ >> 6;
  char* wsl = ows(p);
  const float* ada = (const float*)(wsl + OFF_ADA);
  bf16_t* H = (bf16_t*)(wsl + OFF_H);
  const int rstep = gridDim.x * NWAVE;
  float4 nx[4];
  {
    const int row0 = blockIdx.x * NWAVE + wave;
    if (row0 < T) {
#pragma unroll
      for (int i = 0; i < 4; ++i) nx[i] = ((const float4*)(p->x + (size_t)row0 * D))[i * 64 + lane];
    }
  }
  for (int row = blockIdx.x * NWAVE + wave; row < T; row += rstep) {
    const int b = row >> 12;
    float4 v[4];
    float ss = 0.f;
#pragma unroll
    for (int i = 0; i < 4; ++i) v[i] = nx[i];
    if (row + rstep < T) {
#pragma unroll
      for (int i = 0; i < 4; ++i) nx[i] = ((const float4*)(p->x + (size_t)(row + rstep) * D))[i * 64 + lane];
    }
#pragma unroll
    for (int i = 0; i < 4; ++i) ss += v[i].x * v[i].x + v[i].y * v[i].y + v[i].z * v[i].z + v[i].w * v[i].w;
    ss = wave_sum(ss);
    const float rstd = rsqrtf(ss * (1.f / 1024.f) + 1e-6f);
    const float* sh = ada + b * 6144, * sc = ada + b * 6144 + 1024;
#pragma unroll
    for (int i = 0; i < 4; ++i) {
      const int col = (i * 64 + lane) * 4;
      const float4 g = *(const float4*)(p->g_pre_mix + col);
      const float4 s1 = *(const float4*)(sc + col);
      const float4 s0 = *(const float4*)(sh + col);
      st4(H + (size_t)row * D + col, v[i].x * rstd * g.x * (1.f + s1.x) + s0.x, v[i].y * rstd * g.y * (1.f + s1.y) + s0.y,
          v[i].z * rstd * g.z * (1.f + s1.z) + s0.z, v[i].w * rstd * g.w * (1.f + s1.w) + s0.w);
    }
  }
}

DI void rope_angles(int pos, int d, float& cs, float& sn) {
  const float c = __builtin_amdgcn_exp2f(-(float)d * 0.8304820237218405f) * 0.15915494309189535f;
  const float t = __builtin_amdgcn_fractf((float)pos * c);
  sn = __builtin_amdgcn_sinf(t); cs = __builtin_amdgcn_cosf(t);
}

DI void gates_epilogue16(const f32x4v (&acc)[8][4], char* ws, int tokb, int fo, int fr, int fq) {
  bf16_t* dst = (bf16_t*)(ws + OFF_GATES);
#pragma unroll
  for (int n = 0; n < 4; ++n)
#pragma unroll
    for (int m = 0; m < 8; ++m)
      st4(dst + (size_t)(tokb + n * 16 + fr) * 2048 + fo + m * 16 + 4 * fq, sigm(acc[m][n][0]), sigm(acc[m][n][1]), sigm(acc[m][n][2]), sigm(acc[m][n][3]));
}

DI void phase2(KP p, char* lds) {
  const int tid = otid(), lane = tid & 63, wave = tid >> 6;
  const int fr = lane & 15, fq = lane >> 4, wr = wave >> 2, wc = wave & 3;
  char* ws = ows(p);
  const bf16_t* H = (const bf16_t*)(ws + OFF_H);
  const bf16_t* W = (const bf16_t*)(ws + OFF_WIN);
  for (int k_ = 0;; ++k_) {
    int tn, tm; if (!tile_coord(k_, 12, tm, tn)) break;
    if (tn == 11) tn = 12;
    f32x4v acc[8][4];
    gemm_tile16(H + (size_t)tm * 256 * 1024, 1024, W + (size_t)tn * 256 * 1024, 1024, 1024, acc, lds);
    const int tokb = tm * 256 + wc * 64;
    const int hidx = tn * 2 + wr;
    if (hidx < 5) {
      bf16_t* dst; int ld, fo; float* ssa;
      if (hidx < 3) { dst = (bf16_t*)(ws + OFF_QLAT); ld = 384; fo = hidx * 128; ssa = (float*)(ws + OFF_SSQ); }
      else { dst = (bf16_t*)(ws + OFF_KVLAT); ld = 256; fo = (hidx - 3) * 128; ssa = (float*)(ws + OFF_SSKV); }
#pragma unroll
      for (int n = 0; n < 4; ++n) {
        const int tok = tokb + n * 16 + fr;
        float ss = 0.f;
#pragma unroll
        for (int m = 0; m < 8; ++m) {
          const float a = acc[m][n][0], b = acc[m][n][1], c = acc[m][n][2], d = acc[m][n][3];
          ss += a * a + b * b + c * c + d * d;
          st4(dst + (size_t)tok * ld + fo + m * 16 + 4 * fq, a, b, c, d);
        }
        ss += __shfl_xor(ss, 16);
        ss += __shfl_xor(ss, 32);
        if (fq == 0) atomicAdd(ssa + tok, ss);
      }
    } else if (hidx < 9) {
      bf16_t* dst = (bf16_t*)(ws + OFF_U);
      const int fo = (hidx - 5) * 128;
#pragma unroll
      for (int n = 0; n < 4; ++n)
#pragma unroll
        for (int m = 0; m < 8; ++m)
          st4(dst + (size_t)(tokb + n * 16 + fr) * 512 + fo + m * 16 + 4 * fq, acc[m][n][0], acc[m][n][1], acc[m][n][2], acc[m][n][3]);
    } else if (hidx < 25) {
      gates_epilogue16(acc, ws, tokb, (hidx - 9) * 128, fr, fq);
    } else {
      bf16_t* dst = (bf16_t*)(ws + OFF_KROPE);
#pragma unroll
      for (int n = 0; n < 4; ++n) {
        const int tok = tokb + n * 16 + fr;
        const int pos = p->pos[tok];
        float o0[4], o1[4];
#pragma unroll
        for (int j = 0; j < 4; ++j) {
          float cs, sn; rope_angles(pos, 4 * fq + j, cs, sn);
          const float x1 = acc[0][n][j], x2 = acc[1][n][j];
          o0[j] = x1 * cs - x2 * sn; o1[j] = x2 * cs + x1 * sn;
        }
        st4(dst + (size_t)tok * 32 + 4 * fq, o0[0], o0[1], o0[2], o0[3]);
        st4(dst + (size_t)tok * 32 + 16 + 4 * fq, o1[0], o1[1], o1[2], o1[3]);
      }
    }
  }
}

template <bool PASS2>
DI void s5_wave_item(KP p, int w, char* lds_wave) {
  const int lane = otid() & 63;
  const int r = lane & 31, hh = lane >> 5;
  const int k = w & 31, g = (w >> 5) & 31, b = w >> 10;
  char* ws = ows(p);
  const bf16_t* U = (const bf16_t*)(ws + OFF_U);
  const float2* SA = (const float2*)(ws + OFF_SA);
  const float2* SAL = (const float2*)(ws + OFF_SAL);
  const bf16_t* BBT = (const bf16_t*)(ws + OFF_BBT);
  const bf16_t* CMT = (const bf16_t*)(ws + OFF_CMT);
  float2* E = (float2*)(ws + OFF_E);
  const int my_chunk = 2 * k + hh;
  const int a_chunk = 2 * k + ((r >> 2) & 1);
  const int a_idx = (r & 3) + 4 * (r >> 3);
  const bf16_t* ua = U + ((size_t)(b * SEQ + a_chunk * 64 + a_idx)) * 512 + g * 16 + 8 * hh;
  bf16x8 af_nxt = *(const bf16x8*)ua;
  char* Hs = lds_wave;
  float* Yf = (float*)(lds_wave + 8704);
  f32x16 zero;
#pragma unroll
  for (int i = 0; i < 16; ++i) zero[i] = 0.f;
  const int yfr = lane & 15, yfq = lane >> 4;
  const float dsk = PASS2 ? p->ssm_d[g * 16 + yfr] : 0.f;

#pragma unroll 1
  for (int d = 0; d < 2; ++d) {
    const int dg = d * 32 + g;
    const float2 a0 = SA[dg * 64 + r], a1 = SA[dg * 64 + 32 + r];
    bf16x8 bfr[4];
#pragma unroll
    for (int q = 0; q < 4; ++q) bfr[q] = *(const bf16x8*)(BBT + (size_t)(dg * 128 + 32 * q + r) * 16 + 8 * hh);
    float h0r = 0.f, h0i = 0.f, h1r = 0.f, h1i = 0.f;
    bf16x8 cfr[4];
    if (PASS2) {
      const bf16_t* cptr = CMT + (size_t)(dg * 16 + yfr) * 128 + 8 * yfq;
#pragma unroll
      for (int s = 0; s < 4; ++s) cfr[s] = *(const bf16x8*)(cptr + 32 * s);
      const float2* Sb = (const float2*)(ws + OFF_S) + ((size_t)((d * 4 + b) * 32 + g) * 64 + my_chunk) * 64;
      const float2 s0 = Sb[r], s1 = Sb[32 + r];
      h0r = s0.x; h0i = s0.y; h1r = s1.x; h1i = s1.y;
    }
#pragma unroll 1
    for (int sbi = 0; sbi < 4; ++sbi) {
      const int sbx = (d == 0) ? sbi : 3 - sbi;
      const bf16x8 af = af_nxt;
      {
        const int qn = d * 4 + sbi + 1;
        const int sbn = (qn < 4 ? qn : 7 - qn) & 3;
        af_nxt = *(const bf16x8*)(ua + (size_t)(sbn * 16) * 512);
      }
#pragma unroll
      for (int half = 0; half < 2; ++half) {
        f32x16 XR = MFMA(af, bfr[half], zero), XI = MFMA(af, bfr[2 + half], zero);
        const float2 aa = half ? a1 : a0;
        float hr = half ? h1r : h0r, hi = half ? h1i : h0i;
        if (d == 0) {
#pragma unroll
          for (int i = 0; i < 16; ++i) {
            const float t0 = aa.x * hr - aa.y * hi + XR[i]; const float t1 = aa.x * hi + aa.y * hr + XI[i]; hr = t0; hi = t1; XR[i] = t0; XI[i] = t1;
          }
        } else {
#pragma unroll
          for (int i = 15; i >= 0; --i) {
            const float t0 = aa.x * hr - aa.y * hi + XR[i]; const float t1 = aa.x * hi + aa.y * hr + XI[i]; hr = t0; hi = t1; XR[i] = t0; XI[i] = t1;
          }
        }
        if (half) { h1r = hr; h1i = hi; } else { h0r = hr; h0i = hi; }
        if (PASS2) {
#pragma unroll
          for (int i = 0; i < 16; ++i) *(unsigned*)(Hs + crow(i, hh) * 272 + 4 * (r + 32 * half)) = pack2(XR[i], XI[i]);
        }
      }
      if (PASS2) {
        const int sb = sbx;
        f32x4v yv[2];
        yv[0] = (f32x4v){0.f, 0.f, 0.f, 0.f}; yv[1] = yv[0];
#pragma unroll
        for (int s4 = 0; s4 < 4; ++s4)
#pragma unroll
          for (int mt = 0; mt < 2; ++mt) {
            const bf16x8 hf = *(const bf16x8*)(Hs + (mt * 16 + yfr) * 272 + (32 * s4 + 8 * yfq) * 2);
            yv[mt] = __builtin_amdgcn_mfma_f32_16x16x32_bf16(hf, cfr[s4], yv[mt], 0, 0, 0);
          }
        const int yh = yfq & 1;
        if (d == 0) {
#pragma unroll
          for (int mt = 0; mt < 2; ++mt)
#pragma unroll
            for (int j = 0; j < 4; ++j) {
              const int idx = j + 4 * (2 * mt + (yfq >> 1));
              Yf[(yh * 64 + sb * 16 + idx) * 16 + yfr] = yv[mt][j];
            }
        } else {
          float uval[2][4];
#pragma unroll
          for (int mt = 0; mt < 2; ++mt)
#pragma unroll
            for (int j = 0; j < 4; ++j) {
              const int idx = j + 4 * (2 * mt + (yfq >> 1));
              const size_t tok = (size_t)b * SEQ + (2 * k + yh) * 64 + sb * 16 + idx;
              uval[mt][j] = bf2f(U[tok * 512 + g * 16 + yfr]);
            }
#pragma unroll
          for (int mt = 0; mt < 2; ++mt)
#pragma unroll
            for (int j = 0; j < 4; ++j) {
              const int idx = j + 4 * (2 * mt + (yfq >> 1));
              const float tot = yv[mt][j] + Yf[(yh * 64 + sb * 16 + idx) * 16 + yfr] + dsk * uval[mt][j];
              *(bf16_t*)(Hs + ((yh * 16 + idx) * 16 + yfr) * 2) = f2bf(gelu_tanh(tot));
            }
          {
            const int row = lane >> 1, half = lane & 1;
            const uint4 val = *(const uint4*)(Hs + row * 32 + half * 16);
            const size_t tok = (size_t)b * SEQ + (2 * k + (row >> 4)) * 64 + sb * 16 + (row & 15);
            *(uint4*)((bf16_t*)(ws + OFF_YG) + tok * 512 + g * 16 + half * 8) = val;
          }
        }
      }
    }
    if (!PASS2) {
      float2* Eb = E + ((size_t)((d * 4 + b) * 32 + g) * 64 + my_chunk) * 64;
      Eb[r] = make_float2(h0r, h0i);
      Eb[32 + r] = make_float2(h1r, h1i);
    }
  }
}

DI void phase3(KP p, char* lds) {
  const int tid = otid(), lane = tid & 63, wave = tid >> 6;
  const int r = lane & 31, hh = lane >> 5, wn = wave & 1, wm = wave >> 1;
  char* ws = ows(p);
  constexpr int NS = 512;
  for (int v = blockIdx.x; v < NS; v += gridDim.x) s5_wave_item<false>(p, v * NWAVE + wave, lds + wave * S5_WAVE_LDS);
  __syncthreads();
  {
    const bool generic = (gridDim.x & 7) != 0 || (gridDim.x >> 3) <= 8;
    const int xcd = blockIdx.x & 7, j = blockIdx.x >> 3, nper = generic ? 1 : (int)(gridDim.x >> 3);
    const int jj = generic ? 0 : (j + nper - (24 % nper)) % nper;
    const int l0 = generic ? (int)blockIdx.x : jj, lstep = generic ? (int)gridDim.x : nper, lend = generic ? 64 : 8;
    for (int l = l0; l < lend; l += lstep) {
      const int tm = generic ? l : xcd * 8 + l;
      f32x4v acc[8][4];
      gemm_tile16((const bf16_t*)(ws + OFF_H) + (size_t)tm * 256 * 1024, 1024, (const bf16_t*)(ws + OFF_WIN) + (size_t)11 * 256 * 1024, 1024, 1024, acc, lds);
      gates_epilogue16(acc, ws, tm * 256 + (wave & 3) * 64, (22 + (wave >> 2) - 9) * 128, lane & 15, lane >> 4);
    }
    if (generic) phase0_deferred(p, lds, blockIdx.x, gridDim.x);
    else if (jj >= 8) phase0_deferred(p, lds, xcd * (nper - 8) + (jj - 8), 8 * (nper - 8));
  }
  {
    const int fr = lane & 15, fq = lane >> 4, wr = wave >> 2, wc = wave & 3;
    for (int k_ = 0;; ++k_) {
      int tn, tm; if (!tile_coord(k_, 3, tm, tn)) break;
      f32x4v acc[8][4];
      float ssq_pre[4]; int pos_pre[4];
#pragma unroll
      for (int n = 0; n < 4; ++n) { const int tok_ = tm * 256 + wc * 64 + n * 16 + fr; ssq_pre[n] = ((const float*)(ws + OFF_SSQ))[tok_]; pos_pre[n] = p->pos[tok_]; }
      gemm_tile16((const bf16_t*)(ws + OFF_QLAT) + (size_t)tm * 256 * 384, 384, (const bf16_t*)(ws + OFF_WUQ) + (size_t)tn * 256 * 384, 384, 384, acc, lds);
      bf16_t* Q = (bf16_t*)(ws + OFF_Q);
      const float qscale = 0.10206207261596575f * 1.4426950408889634f;
#pragma unroll
      for (int n = 0; n < 4; ++n) {
        const int tok = tm * 256 + wc * 64 + n * 16 + fr;
        const int b = tok >> 12, sq = tok & 4095;
        const float sc = rsqrtf(ssq_pre[n] * (1.f / 384.f) + 1e-6f) * qscale;
        const int pos = pos_pre[n];
#pragma unroll
        for (int mp = 0; mp < 4; ++mp) {
          const int sidx = tn * 8 + wr * 4 + mp;
          const int head = sidx / 3, part = sidx - head * 3;
          float o0[4], o1[4];
          if (part == 2) {
#pragma unroll
            for (int j = 0; j < 4; ++j) {
              float cs, sn; rope_angles(pos, 4 * fq + j, cs, sn);
              const float x1 = acc[2 * mp][n][j] * sc, x2 = acc[2 * mp + 1][n][j] * sc;
              o0[j] = x1 * cs - x2 * sn; o1[j] = x2 * cs + x1 * sn;
            }
          } else {
#pragma unroll
            for (int j = 0; j < 4; ++j) { o0[j] = acc[2 * mp][n][j] * sc; o1[j] = acc[2 * mp + 1][n][j] * sc; }
          }
          bf16_t* dst = Q + ((size_t)((b * 8 + head) * SEQ + sq)) * 96 + part * 32 + 4 * fq;
          st4(dst, o0[0], o0[1], o0[2], o0[3]);
          st4(dst + 16, o1[0], o1[1], o1[2], o1[3]);
        }
      }
    }
    for (int k_ = 0;; ++k_) {
      int tn, tm; if (!tile_coord(k_, 4, tm, tn)) break;
      f32x4v acc[8][4];
      const float* sskv = (const float*)(ws + OFF_SSKV);
      if (tn < 2) {
        gemm_tile16((const bf16_t*)(ws + OFF_KVLAT) + (size_t)tm * 256 * 256, 256, (const bf16_t*)(ws + OFF_WUKV) + (size_t)tn * 256 * 256, 256, 256, acc, lds);
#pragma unroll
        for (int n = 0; n < 4; ++n) {
          const int tok = tm * 256 + wc * 64 + n * 16 + fr;
          const int b = tok >> 12, sq = tok & 4095;
          const float sc = rsqrtf(sskv[tok] * (1.f / 256.f) + 1e-6f);
#pragma unroll
          for (int m = 0; m < 8; ++m) {
            const int f = tn * 256 + wr * 128 + m * 16 + 4 * fq;
            const int head = f >> 6, d0 = f & 63;
            st4((bf16_t*)(ws + OFF_KN) + ((size_t)((b * 8 + head) * SEQ + sq)) * 64 + d0, acc[m][n][0] * sc, acc[m][n][1] * sc, acc[m][n][2] * sc, acc[m][n][3] * sc);
          }
        }
      } else {
        gemm_tile16((const bf16_t*)(ws + OFF_WUKV) + (size_t)tn * 256 * 256, 256, (const bf16_t*)(ws + OFF_KVLAT) + (size_t)tm * 256 * 256, 256, 256, acc, lds);
#pragma unroll
        for (int n = 0; n < 4; ++n) {
          const int f = (tn - 2) * 256 + wc * 64 + n * 16 + fr;
          const int head = f >> 6, dv = f & 63;
#pragma unroll
          for (int m = 0; m < 8; ++m) {
            const int tok = tm * 256 + wr * 128 + m * 16 + 4 * fq;
            const int b = tok >> 12, sq = tok & 4095;
            const float4 ssv = *(const float4*)(sskv + tok);
            st4((bf16_t*)(ws + OFF_VT) + ((size_t)((b * 8 + head) * 64 + dv)) * SEQ + sq,
                acc[m][n][0] * rsqrtf(ssv.x * (1.f / 256.f) + 1e-6f), acc[m][n][1] * rsqrtf(ssv.y * (1.f / 256.f) + 1e-6f),
                acc[m][n][2] * rsqrtf(ssv.z * (1.f / 256.f) + 1e-6f), acc[m][n][3] * rsqrtf(ssv.w * (1.f / 256.f) + 1e-6f));
          }
        }
      }
    }
  }
}

template <int NQ>
DI void attn_item(KP p, int item, char* lds) {
  const int tid = otid(), lane = tid & 63, wave = tid >> 6;
  const int r = lane & 31, hh = lane >> 5;
  constexpr int NQB = 16 / NQ, LQ = (NQ == 2) ? 3 : 4;
  const int qb = item & (NQB - 1), h = (item >> LQ) & 7, b = item >> (LQ + 3);
  char* ws = ows(p);
  const bf16_t* Q = (const bf16_t*)(ws + OFF_Q) + ((size_t)(b * 8 + h) * SEQ) * 96;
  const bf16_t* Kn = (const bf16_t*)(ws + OFF_KN) + ((size_t)(b * 8 + h) * SEQ) * 64;
  const bf16_t* Kr = (const bf16_t*)(ws + OFF_KROPE) + (size_t)b * SEQ * 32;
  const bf16_t* Vt = (const bf16_t*)(ws + OFF_VT) + ((size_t)(b * 8 + h) * 64) * SEQ;
  const int q0 = qb * (256 * NQ) + wave * (32 * NQ) + r;
  bf16x8 qf[NQ][6];
#pragma unroll
  for (int u = 0; u < NQ; ++u)
#pragma unroll
    for (int ks = 0; ks < 6; ++ks) qf[u][ks] = *(const bf16x8*)(Q + (size_t)(q0 + 32 * u) * 96 + ks * 16 + hh * 8);
  constexpr int ST = 43520, VOFF = 26624, VRS = 264;
  uint4 kreg0, kreg1, kreg2, vreg0, vreg1;
  const int krow_ = tid >> 3, kc8 = tid & 7;
  const int rrow = tid >> 2, rc4 = tid & 3;
  const bf16_t* kp0 = Kn + (size_t)krow_ * 64 + kc8 * 8;
  const bf16_t* kp2 = Kr + (size_t)rrow * 32 + rc4 * 8;
  const bf16_t* vp0 = Vt + (size_t)krow_ * SEQ + kc8 * 8;
  char* const kw0 = lds + krow_ * 208 + kc8 * 16;
  char* const kw2 = lds + rrow * 208 + 128 + rc4 * 16;
  char* const vw0 = lds + VOFF + krow_ * VRS + kc8 * 16;
#define ATT_GLOAD(k0) { kreg0 = *(const uint4*)(kp0 + (size_t)(k0) * 64); kreg1 = *(const uint4*)(kp0 + (size_t)((k0) + 64) * 64); kreg2 = *(const uint4*)(kp2 + (size_t)(k0) * 32); \
    vreg0 = *(const uint4*)(vp0 + (k0)); vreg1 = *(const uint4*)(vp0 + (k0) + 64); }
#define ATT_SWRITE(st) { const int so = (st) * ST; *(uint4*)(kw0 + so) = kreg0; *(uint4*)(kw0 + so + 64 * 208) = kreg1; *(uint4*)(kw2 + so) = kreg2; \
    *(uint2*)(vw0 + so) = make_uint2(vreg0.x, vreg0.y); *(uint2*)(vw0 + so + 8) = make_uint2(vreg0.z, vreg0.w); \
    *(uint2*)(vw0 + so + 128) = make_uint2(vreg1.x, vreg1.y); *(uint2*)(vw0 + so + 136) = make_uint2(vreg1.z, vreg1.w); }
  f32x16 oacc[NQ][2];
  float m[NQ], lsum[NQ];
#pragma unroll
  for (int u = 0; u < NQ; ++u) {
    m[u] = -INFINITY; lsum[u] = 0.f;
#pragma unroll
    for (int i = 0; i < 16; ++i) { oacc[u][0][i] = 0.f; oacc[u][1][i] = 0.f; }
  }
  ATT_GLOAD(0); ATT_SWRITE(0); __syncthreads();
  constexpr int NT = SEQ / 128;
#pragma unroll 1
  for (int t = 0; t < NT; ++t) {
    const bool more = (t + 1 < NT);
    if (more) ATT_GLOAD((t + 1) * 128);
#pragma unroll
    for (int hf = 0; hf < 2; ++hf) {
      const char* base = lds + (t & 1) * ST + hf * (64 * 208);
      const char* vbase = lds + (t & 1) * ST + VOFF + hf * 128;
      f32x16 s[NQ][2];
#pragma unroll
      for (int kt = 0; kt < 2; ++kt) {
#pragma unroll
        for (int u = 0; u < NQ; ++u)
#pragma unroll
          for (int i = 0; i < 16; ++i) s[u][kt][i] = 0.f;
#pragma unroll
        for (int ks = 0; ks < 6; ++ks) {
          const bf16x8 kf = *(const bf16x8*)(base + (kt * 32 + r) * 208 + ks * 32 + hh * 16);
#pragma unroll
          for (int u = 0; u < NQ; ++u) s[u][kt] = MFMA(kf, qf[u][ks], s[u][kt]);
        }
      }
#pragma unroll
      for (int u = 0; u < NQ; ++u) {
        if (t == 0 && hf == 0) {
          float mx = s[u][0][0];
#pragma unroll
          for (int i = 1; i < 16; ++i) mx = fmaxf(mx, s[u][0][i]);
#pragma unroll
          for (int i = 0; i < 16; ++i) mx = fmaxf(mx, s[u][1][i]);
          const unsigned mu = __float_as_uint(mx);
          const auto sw = __builtin_amdgcn_permlane32_swap(mu, mu, false, false);
          m[u] = fmaxf(__uint_as_float(sw[0]), __uint_as_float(sw[1]));
        }
        const float mref = m[u];
        float ps = 0.f;
#pragma unroll
        for (int kt = 0; kt < 2; ++kt)
#pragma unroll
          for (int i = 0; i < 16; ++i) { const float pv = __builtin_amdgcn_exp2f(s[u][kt][i] - mref); s[u][kt][i] = pv; ps += pv; }
        if (__any(ps > 4096.f)) {
          float pm = s[u][0][0];
#pragma unroll
          for (int i = 1; i < 16; ++i) pm = fmaxf(pm, s[u][0][i]);
#pragma unroll
          for (int i = 0; i < 16; ++i) pm = fmaxf(pm, s[u][1][i]);
          const unsigned mu = __float_as_uint(pm);
          const auto sw = __builtin_amdgcn_permlane32_swap(mu, mu, false, false);
          pm = fmaxf(fmaxf(__uint_as_float(sw[0]), __uint_as_float(sw[1])), 1.f);
          const float alpha = __builtin_amdgcn_rcpf(pm);
          m[u] = mref + __builtin_amdgcn_logf(pm);
          lsum[u] *= alpha; ps *= alpha;
#pragma unroll
          for (int i = 0; i < 16; ++i) { oacc[u][0][i] *= alpha; oacc[u][1][i] *= alpha; s[u][0][i] *= alpha; s[u][1][i] *= alpha; }
        }
        lsum[u] += ps;
      }
#pragma unroll
      for (int kt = 0; kt < 2; ++kt)
#pragma unroll
        for (int s2 = 0; s2 < 2; ++s2) {
          bf16x8 pf[NQ];
#pragma unroll
          for (int u = 0; u < NQ; ++u) {
            u32x4 pu;
            pu.x = pack2(s[u][kt][8 * s2 + 0], s[u][kt][8 * s2 + 1]); pu.y = pack2(s[u][kt][8 * s2 + 2], s[u][kt][8 * s2 + 3]);
            pu.z = pack2(s[u][kt][8 * s2 + 4], s[u][kt][8 * s2 + 5]); pu.w = pack2(s[u][kt][8 * s2 + 6], s[u][kt][8 * s2 + 7]);
            pf[u] = __builtin_bit_cast(bf16x8, pu);
          }
#pragma unroll
          for (int dt = 0; dt < 2; ++dt) {
            const char* va = vbase + (dt * 32 + r) * VRS + (kt * 32 + 16 * s2 + 4 * hh) * 2;
            const uint2 v0 = *(const uint2*)va;
            const uint2 v1 = *(const uint2*)(va + 16);
            u32x4 vu; vu.x = v0.x; vu.y = v0.y; vu.z = v1.x; vu.w = v1.y;
            const bf16x8 vf = __builtin_bit_cast(bf16x8, vu);
#pragma unroll
            for (int u = 0; u < NQ; ++u) oacc[u][dt] = MFMA(vf, pf[u], oacc[u][dt]);
          }
        }
    }
    if (more) ATT_SWRITE((t + 1) & 1);
    __syncthreads();
  }
#pragma unroll
  for (int u = 0; u < NQ; ++u) {
    const float l = lsum[u] + __shfl_xor(lsum[u], 32);
    const float inv = __builtin_amdgcn_rcpf(l);
    bf16_t* O = (bf16_t*)(ws + OFF_O) + ((size_t)(b * SEQ + q0 + 32 * u)) * 512 + h * 64 + 4 * hh;
#pragma unroll
    for (int dt = 0; dt < 2; ++dt)
#pragma unroll
      for (int qq = 0; qq < 4; ++qq)
        st4(O + dt * 32 + 8 * qq, oacc[u][dt][4 * qq] * inv, oacc[u][dt][4 * qq + 1] * inv, oacc[u][dt][4 * qq + 2] * inv, oacc[u][dt][4 * qq + 3] * inv);
  }
}

DI void phase_carry(KP p) {
  const int tid = otid(), lane = tid & 63, wave = tid >> 6;
  char* ws = ows(p);
  if (wave != 0) return;
  for (int u = blockIdx.x; u < 256; u += gridDim.x) {
    const int g = u & 31, d = u >> 7;
    const float2 aL = ((const float2*)(ws + OFF_SAL))[(d * 32 + g) * 64 + lane];
    const float2* Eb = (const float2*)(ws + OFF_E) + (size_t)u * 64 * 64;
    float2* Sb = (float2*)(ws + OFF_S) + (size_t)u * 64 * 64;
    float hr = 0.f, hi = 0.f;
#pragma unroll 1
    for (int j0 = 0; j0 < 64; j0 += 32) {
      float2 e[32];
#pragma unroll
      for (int q = 0; q < 32; ++q) { const int c = (d == 0) ? (j0 + q) : 63 - (j0 + q); e[q] = Eb[(size_t)c * 64 + lane]; }
#pragma unroll
      for (int q = 0; q < 32; ++q) {
        const int c = (d == 0) ? (j0 + q) : 63 - (j0 + q);
        Sb[(size_t)c * 64 + lane] = make_float2(hr, hi);
        const float t0 = aL.x * hr - aL.y * hi + e[q].x, t1 = aL.x * hi + aL.y * hr + e[q].y;
        hr = t0; hi = t1;
      }
    }
  }
}

DI void phase4(KP p, char* lds) {
  const int wave = otid() >> 6;
  for (int it = blockIdx.x; it < 512; it += gridDim.x) s5_wave_item<true>(p, it * NWAVE + wave, lds + wave * S5_WAVE_LDS);
  __syncthreads();
}

DI void phase5(KP p, char* lds) {
  for (int it = blockIdx.x; it < 512 / ATT_NQ; it += gridDim.x) attn_item<ATT_NQ>(p, it, lds);
  const int tid = otid(), lane = tid & 63, wave = tid >> 6;
  const int fr = lane & 15, fq = lane >> 4, wr = wave >> 2, wc = wave & 3;
  char* ws = ows(p);
  for (int k_ = 0;; ++k_) {
    int tn, tm; if (!tile_coord(k_, 8, tm, tn)) break;
    f32x4v acc[8][4];
    gemm_tile16((const bf16_t*)(ws + OFF_YG) + (size_t)tm * 256 * 512, 512, (const bf16_t*)(ws + OFF_WGLU) + (size_t)tn * 256 * 512, 512, 512, acc, lds);
    const bf16_t* G = (const bf16_t*)(ws + OFF_GATES);
    bf16_t* BB = (bf16_t*)(ws + OFF_BB);
#pragma unroll
    for (int n = 0; n < 4; ++n) {
      const int tok = tm * 256 + wc * 64 + n * 16 + fr;
#pragma unroll
      for (int pm = 0; pm < 4; ++pm) {
        const int f = tn * 128 + wr * 64 + pm * 16 + 4 * fq;
        const uint2 gb = *(const uint2*)(G + (size_t)tok * 2048 + 1024 + f);
        const float gbv[4] = {bflo(gb.x), bfhi(gb.x), bflo(gb.y), bfhi(gb.y)};
        float o[4];
#pragma unroll
        for (int j = 0; j < 4; ++j) o[j] = gbv[j] * acc[2 * pm][n][j] * sigm(acc[2 * pm + 1][n][j]);
        st4(BB + (size_t)tok * 1024 + f, o[0], o[1], o[2], o[3]);
      }
    }
  }
}

DI void phase6(KP p, char* lds) {
  const int tid = otid(), lane = tid & 63, wave = tid >> 6;
  const int fr = lane & 15, fq = lane >> 4, wr = wave >> 2, wc = wave & 3;
  char* ws = ows(p);
  for (int k_ = 0;; ++k_) {
    int tn, tm; if (!tile_coord(k_, 4, tm, tn)) break;
    f32x4v acc[8][4];
    gemm_tile16((const bf16_t*)(ws + OFF_O) + (size_t)tm * 256 * 512, 512, (const bf16_t*)(ws + OFF_WO) + (size_t)tn * 256 * 512, 512, 512, acc, lds);
    const bf16_t* G = (const bf16_t*)(ws + OFF_GATES);
    const bf16_t* BB = (const bf16_t*)(ws + OFF_BB);
    bf16_t* M = (bf16_t*)(ws + OFF_M);
#pragma unroll
    for (int n = 0; n < 4; ++n) {
      const int tok = tm * 256 + wc * 64 + n * 16 + fr;
#pragma unroll
      for (int m = 0; m < 8; ++m) {
        const int f = tn * 256 + wr * 128 + m * 16 + 4 * fq;
        const uint2 ga = *(const uint2*)(G + (size_t)tok * 2048 + f);
        const uint2 bb = *(const uint2*)(BB + (size_t)tok * 1024 + f);
        st4(M + (size_t)tok * 1024 + f, bflo(ga.x) * acc[m][n][0] + bflo(bb.x), bfhi(ga.x) * acc[m][n][1] + bfhi(bb.x),
            bflo(ga.y) * acc[m][n][2] + bflo(bb.y), bfhi(ga.y) * acc[m][n][3] + bfhi(bb.y));
      }
      asm volatile("" ::: "memory");
    }
  }
}

DI void phase_gemm_ss(KP p, char* lds, size_t offX, int K, size_t offW, size_t offOut, size_t offSS) {
  const int tid = otid(), lane = tid & 63, wave = tid >> 6;
  const int fr = lane & 15, fq = lane >> 4, wr = wave >> 2, wc = wave & 3;
  char* ws = ows(p);
  for (int k_ = 0;; ++k_) {
    int tn, tm; if (!tile_coord(k_, 4, tm, tn)) break;
    f32x4v acc[8][4];
    gemm_tile16((const bf16_t*)(ws + offX) + (size_t)tm * 256 * K, K, (const bf16_t*)(ws + offW) + (size_t)tn * 256 * K, K, K, acc, lds);
    bf16_t* dst = (bf16_t*)(ws + offOut);
    float* ssa = (float*)(ws + offSS);
#pragma unroll
    for (int n = 0; n < 4; ++n) {
      const int tok = tm * 256 + wc * 64 + n * 16 + fr;
      float ss = 0.f;
#pragma unroll
      for (int m = 0; m < 8; ++m) {
        const float a = acc[m][n][0], b = acc[m][n][1], c = acc[m][n][2], d = acc[m][n][3];
        ss += a * a + b * b + c * c + d * d;
        st4(dst + (size_t)tok * 1024 + tn * 256 + wr * 128 + m * 16 + 4 * fq, a, b, c, d);
      }
      ss += __shfl_xor(ss, 16);
      ss += __shfl_xor(ss, 32);
      if (fq == 0) atomicAdd(ssa + tok, ss);
    }
  }
}

DI void phase7(KP p) {
  const int tid_ = otid(); const int lane = tid_ & 63, wave = tid_ >> 6;
  char* wsl = ows(p);
  const float* ada = (const float*)(wsl + OFF_ADA);
  const bf16_t* MX = (const bf16_t*)(wsl + OFF_MIXED);
  const float* ssm = (const float*)(wsl + OFF_SSM);
  bf16_t* H = (bf16_t*)(wsl + OFF_H);
  const int rstep = gridDim.x * NWAVE;
  float4 nx[4]; uint2 nm[4];
  {
    const int row0 = blockIdx.x * NWAVE + wave;
    if (row0 < T) {
#pragma unroll
      for (int i = 0; i < 4; ++i) { const int col = (i * 64 + lane) * 4; nx[i] = *(const float4*)(p->x + (size_t)row0 * D + col); nm[i] = *(const uint2*)(MX + (size_t)row0 * D + col); }
    }
  }
  for (int row = blockIdx.x * NWAVE + wave; row < T; row += rstep) {
    const int b = row >> 12;
    const float rm = rsqrtf(ssm[row] * (1.f / 1024.f) + 1e-6f);
    const float* gt1 = ada + b * 6144 + 2048, * sh2 = ada + b * 6144 + 3072, * sc2 = ada + b * 6144 + 4096;
    float4 v[4], cx[4]; uint2 cm[4];
    float ss = 0.f;
#pragma unroll
    for (int i = 0; i < 4; ++i) { cx[i] = nx[i]; cm[i] = nm[i]; }
    if (row + rstep < T) {
#pragma unroll
      for (int i = 0; i < 4; ++i) { const int col = (i * 64 + lane) * 4; nx[i] = *(const float4*)(p->x + (size_t)(row + rstep) * D + col); nm[i] = *(const uint2*)(MX + (size_t)(row + rstep) * D + col); }
    }
#pragma unroll
    for (int i = 0; i < 4; ++i) {
      const int col = (i * 64 + lane) * 4;
      const float4 xv = cx[i];
      const uint2 mv = cm[i];
      const float4 g = *(const float4*)(p->g_post_mix + col);
      const float4 gt = *(const float4*)(gt1 + col);
      v[i].x = xv.x + gt.x * (bflo(mv.x) * rm * g.x);
      v[i].y = xv.y + gt.y * (bfhi(mv.x) * rm * g.y);
      v[i].z = xv.z + gt.z * (bflo(mv.y) * rm * g.z);
      v[i].w = xv.w + gt.w * (bfhi(mv.y) * rm * g.w);
      ss += v[i].x * v[i].x + v[i].y * v[i].y + v[i].z * v[i].z + v[i].w * v[i].w;
    }
    ss = wave_sum(ss);
    const float rstd = rsqrtf(ss * (1.f / 1024.f) + 1e-6f);
#pragma unroll
    for (int i = 0; i < 4; ++i) {
      const int col = (i * 64 + lane) * 4;
      const float4 g = *(const float4*)(p->g_pre_ffn + col);
      const float4 s1 = *(const float4*)(sc2 + col);
      const float4 s0 = *(const float4*)(sh2 + col);
      st4(H + (size_t)row * D + col, v[i].x * rstd * g.x * (1.f + s1.x) + s0.x, v[i].y * rstd * g.y * (1.f + s1.y) + s0.y,
          v[i].z * rstd * g.z * (1.f + s1.z) + s0.z, v[i].w * rstd * g.w * (1.f + s1.w) + s0.w);
    }
  }
}

DI void phase9(KP p, char* lds) {
  const int tid = otid(), lane = tid & 63, wave = tid >> 6;
  const int fr = lane & 15, fq = lane >> 4, wr = wave >> 2, wc = wave & 3;
  char* ws = ows(p);
  bf16_t* A = (bf16_t*)(ws + OFF_ACT);
  for (int k_ = 0;; ++k_) {
    int tn, tm; if (!tile_coord(k_, 22, tm, tn)) break;
    f32x4v acc[8][4];
    gemm_tile16((const bf16_t*)(ws + OFF_H) + (size_t)tm * 256 * 1024, 1024, (const bf16_t*)(ws + OFF_WFI) + (size_t)tn * 256 * 1024, 1024, 1024, acc, lds);
#pragma unroll
    for (int n = 0; n < 4; ++n) {
      const int tok = tm * 256 + wc * 64 + n * 16 + fr;
#pragma unroll
      for (int pm = 0; pm < 4; ++pm) {
        float o[4];
#pragma unroll
        for (int j = 0; j < 4; ++j) { const float gv = acc[2 * pm][n][j]; o[j] = gv * sigm(gv) * acc[2 * pm + 1][n][j]; }
        st4(A + (size_t)tok * 2816 + tn * 128 + wr * 64 + pm * 16 + 4 * fq, o[0], o[1], o[2], o[3]);
      }
    }
  }
}

DI void phase10(KP p) {
  const int tid_ = otid(); const int lane = tid_ & 63, wave = tid_ >> 6;
  char* wsl = ows(p);
  const float* ada = (const float*)(wsl + OFF_ADA);
  const bf16_t* F = (const bf16_t*)(wsl + OFF_F);
  const bf16_t* MX = (const bf16_t*)(wsl + OFF_MIXED);
  const float* ssf = (const float*)(wsl + OFF_SSF);
  const float* ssm = (const float*)(wsl + OFF_SSM);
  const int rstep = gridDim.x * NWAVE;
  float4 nx[4]; uint2 nm[4], nf[4];
  {
    const int row0 = blockIdx.x * NWAVE + wave;
    if (row0 < T) {
#pragma unroll
      for (int i = 0; i < 4; ++i) { const int col = (i * 64 + lane) * 4; nx[i] = *(const float4*)(p->x + (size_t)row0 * D + col);
        nm[i] = *(const uint2*)(MX + (size_t)row0 * D + col); nf[i] = *(const uint2*)(F + (size_t)row0 * D + col); }
    }
  }
  for (int row = blockIdx.x * NWAVE + wave; row < T; row += rstep) {
    const int b = row >> 12;
    const float rf = rsqrtf(ssf[row] * (1.f / 1024.f) + 1e-6f);
    const float rm = rsqrtf(ssm[row] * (1.f / 1024.f) + 1e-6f);
    const float* gt1 = ada + b * 6144 + 2048;
    const float* gt2 = ada + b * 6144 + 5120;
    float4 cx[4]; uint2 cm[4], cf[4];
#pragma unroll
    for (int i = 0; i < 4; ++i) { cx[i] = nx[i]; cm[i] = nm[i]; cf[i] = nf[i]; }
    if (row + rstep < T) {
#pragma unroll
      for (int i = 0; i < 4; ++i) { const int col = (i * 64 + lane) * 4; nx[i] = *(const float4*)(p->x + (size_t)(row + rstep) * D + col);
        nm[i] = *(const uint2*)(MX + (size_t)(row + rstep) * D + col); nf[i] = *(const uint2*)(F + (size_t)(row + rstep) * D + col); }
    }
#pragma unroll
    for (int i = 0; i < 4; ++i) {
      const int col = (i * 64 + lane) * 4;
      float4 xv = cx[i];
      const uint2 mv = cm[i];
      const uint2 fv = cf[i];
      const float4 g1 = *(const float4*)(p->g_post_mix + col);
      const float4 t1 = *(const float4*)(gt1 + col);
      const float4 g = *(const float4*)(p->g_post_ffn + col);
      const float4 gt = *(const float4*)(gt2 + col);
      xv.x = xv.x + t1.x * (bflo(mv.x) * rm * g1.x);
      xv.y = xv.y + t1.y * (bfhi(mv.x) * rm * g1.y);
      xv.z = xv.z + t1.z * (bflo(mv.y) * rm * g1.z);
      xv.w = xv.w + t1.w * (bfhi(mv.y) * rm * g1.w);
      xv.x += gt.x * (bflo(fv.x) * rf * g.x);
      xv.y += gt.y * (bfhi(fv.x) * rf * g.y);
      xv.z += gt.z * (bflo(fv.y) * rf * g.z);
      xv.w += gt.w * (bfhi(fv.y) * rf * g.w);
      *(float4*)(p->out + (size_t)row * D + col) = xv;
    }
  }
}

__global__ void __launch_bounds__(512, 2) fwd_kernel(Params pk) {
  __shared__ __attribute__((aligned(1024))) char lds[LDS_BYTES];
  const int pb = pk.phase_begin, pe = pk.phase_end;
  volatile LAS unsigned* st = (volatile LAS unsigned*)(lds + 135168);
  if (threadIdx.x == 0) { st[0] = 0u; st[1] = 0u; }
  __syncthreads();
  (void)xcd_barrier_post((unsigned*)(pk.ws + OFF_BAR), st);
  for (int ph = pb; ph < pe; ++ph) {
    KP p = get_kp();
    switch (ph) {
      case 0: phase0(p, lds); break;
      case 1: phase1(p); break;
      case 2: phase2(p, lds); break;
      case 3: phase3(p, lds); break;
      case 4: phase_carry(p); break;
      case 5: phase4(p, lds); break;
      case 6: phase5(p, lds); break;
      case 7: phase6(p, lds); break;
      case 8: phase_gemm_ss(p, lds, OFF_M, 1024, OFF_WMIX, OFF_MIXED, OFF_SSM); break;
      case 9: phase7(p); break;
      case 10: phase9(p, lds); break;
      case 11: phase_gemm_ss(p, lds, OFF_ACT, 2816, OFF_WFO, OFF_F, OFF_SSF); break;
      case 12: phase10(p); break;
    }
    if (ph + 1 < pe) {
      XcdBarrier b; b.bar = (unsigned*)(get_kp()->ws + OFF_BAR); b.x = xb_xcc_id(); b.st = (volatile LAS unsigned*)(lds + 135168);
      xcd_barrier(b);
    }
  }
}

extern "C" void kernel_launch(void* const* d_in, const int* in_sizes, int n_in, void* d_out, int out_size, void* d_ws, size_t ws_size, hipStream_t stream) {
  static int grid_blocks = 0;
  if (!grid_blocks) {
    int dev = 0, cus = 0, per_cu = 0;
    hipGetDevice(&dev);
    hipDeviceGetAttribute(&cus, hipDeviceAttributeMultiprocessorCount, dev);
    hipOccupancyMaxActiveBlocksPerMultiprocessor(&per_cu, fwd_kernel, NTHR, 0);
    if (per_cu > 1) per_cu = 1;
    if (per_cu < 1) per_cu = 1;
    grid_blocks = cus * per_cu;
  }
  Params p{};
  p.x = (const float*)d_in[0]; p.c = (const float*)d_in[1]; p.pos = (const int*)d_in[2]; p.w_ada = (const float*)d_in[3]; p.b_ada = (const float*)d_in[4];
  p.g_pre_mix = (const float*)d_in[5]; p.g_post_mix = (const float*)d_in[6]; p.g_pre_ffn = (const float*)d_in[7]; p.g_post_ffn = (const float*)d_in[8];
  p.w_in = (const float*)d_in[9]; p.g_q = (const float*)d_in[10]; p.g_kv = (const float*)d_in[11]; p.w_uq = (const float*)d_in[12]; p.w_uk = (const float*)d_in[13];
  p.w_uv = (const float*)d_in[14]; p.w_o = (const float*)d_in[15];
  p.lam_re = (const float*)d_in[16]; p.lam_im = (const float*)d_in[17]; p.log_dt = (const float*)d_in[18]; p.b_re = (const float*)d_in[19]; p.b_im = (const float*)d_in[20];
  p.c_re = (const float*)d_in[21]; p.c_im = (const float*)d_in[22]; p.ssm_d = (const float*)d_in[23];
  p.w_glu = (const float*)d_in[24]; p.w_mix = (const float*)d_in[25]; p.w_ffn_in = (const float*)d_in[26]; p.w_ffn_out = (const float*)d_in[27];
  p.out = (float*)d_out; p.ws = (char*)d_ws;
#if COOP
  hipMemsetAsync((char*)d_ws + OFF_BAR, 0, XCD_BAR_WORDS * 4, stream);
  p.phase_begin = 0; p.phase_end = NPHASE;
  void* args[] = {&p};
  hipError_t e = hipLaunchCooperativeKernel((void*)fwd_kernel, dim3(grid_blocks), dim3(NTHR), args, 0, stream);
  if (e != hipSuccess) fprintf(stderr, "cooperative launch failed: %s (grid %d)\n", hipGetErrorString(e), grid_blocks);
#else
  for (int ph = 0; ph < NPHASE; ++ph) {
    p.phase_begin = ph; p.phase_end = ph + 1;
    hipLaunchKernelGGL(fwd_kernel, dim3(grid_blocks), dim3(NTHR), 0, stream, p);
  }
#endif
}
```

```cpp
#include <hip/hip_runtime.h>
#include <hip/hip_cooperative_groups.h>
#include <cstdio>
#include <cstdint>
namespace cg = cooperative_groups;

#ifndef ATT_NQ
#define ATT_NQ 2
#endif
#ifndef COOP
#define COOP 1
#endif

#define DI __device__ __forceinline__
typedef unsigned short bf16_t;
typedef short bf16x8 __attribute__((ext_vector_type(8)));
typedef float f32x16 __attribute__((ext_vector_type(16)));
typedef __bf16 bf16x2_t __attribute__((ext_vector_type(2)));
typedef float f32x2_t __attribute__((ext_vector_type(2)));
typedef unsigned u32x4 __attribute__((ext_vector_type(4)));
#define MFMA(a, b, c) __builtin_amdgcn_mfma_f32_32x32x16_bf16((a), (b), (c), 0, 0, 0)

constexpr int T = 16384, D = 1024, SEQ = 4096;
constexpr int NPHASE = 13;
constexpr int NTHR = 512, NWAVE = 8;
constexpr size_t MiB = 1u << 20;
constexpr size_t OFF_WIN = 0;
constexpr size_t OFF_WUQ = OFF_WIN + (size_t)3328 * 1024 * 2;
constexpr size_t OFF_WUKV = OFF_WUQ + (size_t)768 * 384 * 2;
constexpr size_t OFF_WO = OFF_WUKV + (size_t)1024 * 256 * 2;
constexpr size_t OFF_WGLU = OFF_WO + (size_t)1024 * 512 * 2;
constexpr size_t OFF_WMIX = OFF_WGLU + (size_t)2048 * 512 * 2;
constexpr size_t OFF_WFI = OFF_WMIX + (size_t)1024 * 1024 * 2;
constexpr size_t OFF_WFO = OFF_WFI + (size_t)5632 * 1024 * 2;
constexpr size_t OFF_ADA = 30 * MiB;
constexpr size_t OFF_SSQ = OFF_ADA + 98304;
constexpr size_t OFF_SSKV = OFF_SSQ + 65536;
constexpr size_t OFF_SSM = OFF_SSKV + 65536;
constexpr size_t OFF_SSF = OFF_SSM + 65536;
constexpr size_t OFF_SA = OFF_SSF + 65536;
constexpr size_t OFF_SAL = OFF_SA + 32768;
constexpr size_t OFF_BBT = OFF_SAL + 32768;
constexpr size_t OFF_CMT = OFF_BBT + 262144;
constexpr size_t OFF_BAR = 31 * MiB;
constexpr size_t OFF_E = 32 * MiB;
constexpr size_t OFF_KROPE = 40 * MiB;
constexpr size_t OFF_H = 41 * MiB;
constexpr size_t OFF_YG = 41 * MiB;
constexpr size_t OFF_O = 57 * MiB;
constexpr size_t OFF_GATES = 73 * MiB;
constexpr size_t OFF_U = 137 * MiB;
constexpr size_t OFF_QLAT = 153 * MiB;
constexpr size_t OFF_KVLAT = 165 * MiB;
constexpr size_t OFF_Q = 173 * MiB;
constexpr size_t OFF_KN = 197 * MiB;
constexpr size_t OFF_VT = 213 * MiB;
constexpr size_t OFF_S = 237 * MiB;
constexpr size_t OFF_BB = 137 * MiB;
constexpr size_t OFF_M = 173 * MiB;
constexpr size_t OFF_MIXED = 205 * MiB;
constexpr size_t OFF_ACT = 73 * MiB;
constexpr size_t OFF_F = 41 * MiB;

constexpr int LDS_BYTES = 135168 + 16;
constexpr int XS_BYTES = 256 * 128;
constexpr int STAGE_BYTES = 2 * XS_BYTES;
constexpr int S5_WAVE_LDS = 16896;

struct Params {
  const float* x; const float* c; const int* pos; const float* w_ada; const float* b_ada;
  const float* g_pre_mix; const float* g_post_mix; const float* g_pre_ffn; const float* g_post_ffn;
  const float* w_in; const float* g_q; const float* g_kv; const float* w_uq; const float* w_uk; const float* w_uv; const float* w_o;
  const float* lam_re; const float* lam_im; const float* log_dt; const float* b_re; const float* b_im; const float* c_re; const float* c_im; const float* ssm_d;
  const float* w_glu; const float* w_mix; const float* w_ffn_in; const float* w_ffn_out;
  float* out; char* ws;
  int phase_begin; int phase_end;
};

typedef const Params __attribute__((address_space(4)))* KP;
DI KP get_kp() { KP k = (KP)__builtin_amdgcn_kernarg_segment_ptr(); asm volatile("" : "+s"(k)); return k; }
DI int otid() { int t = threadIdx.x; asm volatile("" : "+v"(t)); return t; }
DI char* ows(KP p) { char* w = p->ws; asm volatile("" : "+s"(w)); return w; }
DI unsigned pack2(float a, float b) {
  f32x2_t v = {a, b};
  bf16x2_t r = __builtin_convertvector(v, bf16x2_t);
  return __builtin_bit_cast(unsigned, r);
}
DI bf16_t f2bf(float a) { return (bf16_t)(pack2(a, 0.f) & 0xffffu); }
DI float bf2f(unsigned v) { return __uint_as_float(v << 16); }
DI float bflo(unsigned v) { return __uint_as_float(v << 16); }
DI float bfhi(unsigned v) { return __uint_as_float(v & 0xffff0000u); }
DI float sigm(float x) { return __builtin_amdgcn_rcpf(1.f + __expf(-x)); }
DI int crow(int i, int hh) { return (i & 3) + 8 * (i >> 2) + 4 * hh; }
DI float gelu_tanh(float x) {
  float z = 0.7978845608028654f * (x + 0.044715f * x * x * x);
  float t = __expf(2.f * z);
  float th = 1.f - 2.f * __builtin_amdgcn_rcpf(t + 1.f);
  return 0.5f * x * (1.f + th);
}


#define XB_TMO      128
#define XB_XCNT(j)  (256  + 64 * (j))
#define XB_XSUB(j)  (1280 + 64 * (j))
#define XB_XGEN(j)  (2304 + 64 * (j))
#define XB_TOP      3328
#define XB_TOPGEN   3392
#define XCD_BAR_WORDS 3456
#define XB_SPIN_CAP (1u << 20)
#define LAS __attribute__((address_space(3)))
DI unsigned xb_ld(unsigned* p) { return __hip_atomic_load(p, __ATOMIC_RELAXED, __HIP_MEMORY_SCOPE_AGENT); }
DI unsigned xb_add(unsigned* p, unsigned v) { return __hip_atomic_fetch_add(p, v, __ATOMIC_RELAXED, __HIP_MEMORY_SCOPE_AGENT); }
DI unsigned xb_xcc_id() { return (unsigned)__builtin_amdgcn_s_getreg((3 << 11) | 20) & 0xFu; }
#define XB_SPIN(cond, bar) do { unsigned _sp = 0; while (cond) { __builtin_amdgcn_s_sleep(1); \
    if ((++_sp & 255u) == 0u) { if (xb_ld(&(bar)[XB_TMO])) break; if (_sp > XB_SPIN_CAP) { atomicAdd(&(bar)[XB_TMO], 1u); break; } } } } while (0)
struct XcdBarrier { unsigned* bar; unsigned x; volatile LAS unsigned* st; };
DI XcdBarrier xcd_barrier_post(unsigned* bar, volatile LAS unsigned* st) {
  XcdBarrier b; b.bar = bar; b.x = xb_xcc_id(); b.st = st;
  if (threadIdx.x == 0) (void)xb_add(&bar[XB_XCNT(b.x)], 1u);
  return b;
}
DI void xcd_barrier_complete(unsigned* bar, unsigned x, unsigned& nloc, unsigned& nx) {
  const unsigned G = gridDim.x * gridDim.y * gridDim.z;
  unsigned sum, cnt, mine, sp = 0u;
  for (;;) {
    sum = 0u; cnt = 0u; mine = 0u;
#pragma unroll
    for (unsigned j = 0; j < 16; ++j) { const unsigned c = xb_ld(&bar[XB_XCNT(j)]); sum += c; cnt += (c > 0u) ? 1u : 0u; mine = (j == x) ? c : mine; }
    if (sum == G) break;
    __builtin_amdgcn_s_sleep(1);
    if ((++sp & 255u) == 0u) { if (xb_ld(&bar[XB_TMO])) break; if (sp > XB_SPIN_CAP) { atomicAdd(&bar[XB_TMO], 1u); break; } }
  }
  nloc = mine > 0u ? mine : 1u; nx = cnt > 0u ? cnt : 1u;
}
DI void xcd_barrier(const XcdBarrier& b) {
  asm volatile("s_waitcnt vmcnt(0)" ::: "memory");
  __syncthreads();
  if (threadIdx.x == 0) {
    unsigned* bar = b.bar;
    __builtin_amdgcn_s_waitcnt(0);
    unsigned nloc = b.st[0], nx = b.st[1];
    if (nloc == 0u) { xcd_barrier_complete(bar, b.x, nloc, nx); b.st[0] = nloc; b.st[1] = nx; }
    const unsigned old = xb_add(&bar[XB_XSUB(b.x)], 1u);
    const unsigned gen = old / nloc;
    if (old + 1u == (gen + 1u) * nloc) {
      __builtin_amdgcn_fence(__ATOMIC_RELEASE, "agent");
      asm volatile("s_waitcnt vmcnt(0)" ::: "memory");
      const unsigned og = xb_add(&bar[XB_TOP], 1u);
      const unsigned tg = og / nx;
      if (og + 1u == (tg + 1u) * nx) xb_add(&bar[XB_TOPGEN], 1u);
      else XB_SPIN(xb_ld(&bar[XB_TOPGEN]) == tg, bar);
      __builtin_amdgcn_fence(__ATOMIC_ACQUIRE, "agent");
      xb_add(&bar[XB_XGEN(b.x)], 1u);
      asm volatile("s_waitcnt vmcnt(0)" ::: "memory");
    } else {
      XB_SPIN(xb_ld(&bar[XB_XGEN(b.x)]) == gen, bar);
      __builtin_amdgcn_fence(__ATOMIC_ACQUIRE, "agent");
      asm volatile("s_waitcnt vmcnt(0)" ::: "memory");
    }
  }
  __syncthreads();
}

DI void gemm_tile(const bf16_t* __restrict__ X, int ldx, const bf16_t* __restrict__ W, int ldw, int K, f32x16 (&acc)[4][2], char* lds) {
  const int tid = otid(), lane = tid & 63, wave = tid >> 6;
  const int r = lane & 31, hh = lane >> 5, wn = wave & 1, wm = wave >> 1;
#pragma unroll
  for (int ft = 0; ft < 4; ++ft)
#pragma unroll
    for (int tt = 0; tt < 2; ++tt)
#pragma unroll
      for (int i = 0; i < 16; ++i) acc[ft][tt][i] = 0.f;
  const int srow = wave * 32 + (lane >> 3);
  const bf16_t* xg[4]; const bf16_t* wg[4];
#pragma unroll
  for (int i = 0; i < 4; ++i) {
    const int row = srow + i * 8;
    const int ch = (lane & 7) ^ ((row >> 1) & 7);
    xg[i] = X + (size_t)row * ldx + ch * 8;
    wg[i] = W + (size_t)row * ldw + ch * 8;
  }
  char* sdst = lds + wave * 4096;
  const int nk = K >> 6;
#define GLDS_STAGE(st, k0) { _Pragma("unroll") for (int i = 0; i < 4; ++i) { \
    __builtin_amdgcn_global_load_lds((const unsigned*)(xg[i] + (k0)), (__attribute__((address_space(3))) unsigned*)(sdst + (st) * STAGE_BYTES + i * 1024), 16, 0, 0); \
    __builtin_amdgcn_global_load_lds((const unsigned*)(wg[i] + (k0)), (__attribute__((address_space(3))) unsigned*)(sdst + (st) * STAGE_BYTES + XS_BYTES + i * 1024), 16, 0, 0); } }
  GLDS_STAGE(0, 0);
  const int fr = (r >> 1) & 7;
  const int xoff = (wm * 64 + r) * 128, woff = XS_BYTES + (wn * 128 + r) * 128;
  for (int ks = 0; ks < nk; ++ks) {
    asm volatile("s_waitcnt vmcnt(0)" ::: "memory");
    __syncthreads();
    if (ks + 1 < nk) GLDS_STAGE((ks + 1) & 1, (ks + 1) << 6);
    const char* sb = lds + (ks & 1) * STAGE_BYTES;
#pragma unroll
    for (int kk = 0; kk < 4; ++kk) {
      const int po = ((2 * kk + hh) ^ fr) * 16;
      bf16x8 bfr[2], afr[4];
#pragma unroll
      for (int tt = 0; tt < 2; ++tt) bfr[tt] = *(const bf16x8*)(sb + xoff + tt * 4096 + po);
#pragma unroll
      for (int ft = 0; ft < 4; ++ft) afr[ft] = *(const bf16x8*)(sb + woff + ft * 4096 + po);
      __builtin_amdgcn_s_setprio(1);
#pragma unroll
      for (int ft = 0; ft < 4; ++ft)
#pragma unroll
        for (int tt = 0; tt < 2; ++tt) acc[ft][tt] = MFMA(afr[ft], bfr[tt], acc[ft][tt]);
      __builtin_amdgcn_s_setprio(0);
    }
  }
  __syncthreads();
#undef GLDS_STAGE
}

DI void gemm_tile_half(const bf16_t* __restrict__ X, int ldx, const bf16_t* __restrict__ W, int ldw, int K, f32x16 (&acc)[2][2], char* lds) {
  const int tid = otid(), lane = tid & 63, wave = tid >> 6;
  const int r = lane & 31, hh = lane >> 5, wn = wave & 1, wm = wave >> 1;
#pragma unroll
  for (int ft = 0; ft < 2; ++ft)
#pragma unroll
    for (int tt = 0; tt < 2; ++tt)
#pragma unroll
      for (int i = 0; i < 16; ++i) acc[ft][tt][i] = 0.f;
  const int srow = wave * 32 + (lane >> 3);
  const int wrow = wave * 16 + (lane >> 3);
  const bf16_t* xg[4]; const bf16_t* wg[2];
#pragma unroll
  for (int i = 0; i < 4; ++i) { const int row = srow + i * 8; xg[i] = X + (size_t)row * ldx + ((lane & 7) ^ ((row >> 1) & 7)) * 8; }
#pragma unroll
  for (int i = 0; i < 2; ++i) { const int row = wrow + i * 8; wg[i] = W + (size_t)row * ldw + ((lane & 7) ^ ((row >> 1) & 7)) * 8; }
  char* sdx = lds + wave * 4096;
  char* sdw = lds + XS_BYTES + wave * 2048;
  const int nk = K >> 6;
#define GLDS_STAGE_H(st, k0) { _Pragma("unroll") for (int i = 0; i < 4; ++i) \
    __builtin_amdgcn_global_load_lds((const unsigned*)(xg[i] + (k0)), (__attribute__((address_space(3))) unsigned*)(sdx + (st) * STAGE_BYTES + i * 1024), 16, 0, 0); \
    _Pragma("unroll") for (int i = 0; i < 2; ++i) \
    __builtin_amdgcn_global_load_lds((const unsigned*)(wg[i] + (k0)), (__attribute__((address_space(3))) unsigned*)(sdw + (st) * STAGE_BYTES + i * 1024), 16, 0, 0); }
  GLDS_STAGE_H(0, 0);
  const int fr = (r >> 1) & 7;
  const int xoff = (wm * 64 + r) * 128, woff = XS_BYTES + (wn * 64 + r) * 128;
  for (int ks = 0; ks < nk; ++ks) {
    asm volatile("s_waitcnt vmcnt(0)" ::: "memory");
    __syncthreads();
    if (ks + 1 < nk) GLDS_STAGE_H((ks + 1) & 1, (ks + 1) << 6);
    const char* sb = lds + (ks & 1) * STAGE_BYTES;
#pragma unroll
    for (int kk = 0; kk < 4; ++kk) {
      const int po = ((2 * kk + hh) ^ fr) * 16;
      bf16x8 bfr[2], afr[2];
#pragma unroll
      for (int tt = 0; tt < 2; ++tt) bfr[tt] = *(const bf16x8*)(sb + xoff + tt * 4096 + po);
#pragma unroll
      for (int ft = 0; ft < 2; ++ft) afr[ft] = *(const bf16x8*)(sb + woff + ft * 4096 + po);
      __builtin_amdgcn_s_setprio(1);
#pragma unroll
      for (int ft = 0; ft < 2; ++ft)
#pragma unroll
        for (int tt = 0; tt < 2; ++tt) acc[ft][tt] = MFMA(afr[ft], bfr[tt], acc[ft][tt]);
      __builtin_amdgcn_s_setprio(0);
    }
  }
  __syncthreads();
#undef GLDS_STAGE_H
}

typedef float f32x4v __attribute__((ext_vector_type(4)));
DI void stage_rc16(int b, int& R, int& C) {
  const int st = b >> 10, sb = b & 1023, swz = sb ^ (((sb >> 9) & 1) << 5);
  R = (st >> 1) * 16 + (swz >> 6); C = (st & 1) * 32 + ((swz & 63) >> 1);
}
DI void gemm_tile16(const bf16_t* __restrict__ X, int ldx, const bf16_t* __restrict__ W, int ldw, int K, f32x4v (&acc)[8][4], char* lds) {
  const int tid = otid(), lane = tid & 63, wave = tid >> 6;
  const int fr = lane & 15, fq = lane >> 4, wr = wave >> 2, wc = wave & 3;
#pragma unroll
  for (int m = 0; m < 8; ++m)
#pragma unroll
    for (int n = 0; n < 4; ++n) acc[m][n] = (f32x4v){0.f, 0.f, 0.f, 0.f};
  int R0, C0; stage_rc16(wave * 1024 + lane * 16, R0, C0);
  const bf16_t* xg0 = X + (size_t)R0 * ldx + C0;
  const bf16_t* wg0 = W + (size_t)R0 * ldw + C0;
  char* sdst = lds + wave * 1024;
  const int nk = K >> 6;
#define GLDS_STAGE16(st, k0) { _Pragma("unroll") for (int i = 0; i < 4; ++i) { \
    __builtin_amdgcn_global_load_lds((const unsigned*)(xg0 + (size_t)(64 * i) * ldx + (k0)), (__attribute__((address_space(3))) unsigned*)(sdst + (st) * STAGE_BYTES + i * 8192), 16, 0, 0); \
    __builtin_amdgcn_global_load_lds((const unsigned*)(wg0 + (size_t)(64 * i) * ldw + (k0)), (__attribute__((address_space(3))) unsigned*)(sdst + (st) * STAGE_BYTES + XS_BYTES + i * 8192), 16, 0, 0); } }
  GLDS_STAGE16(0, 0);
  const int ob = fr * 64 + fq * 16;
  const int lo = ob ^ (((ob >> 9) & 1) << 5);
  const int xoff = (wc * 4) * 2048 + lo, woff = XS_BYTES + (wr * 8) * 2048 + lo;
  for (int ks = 0; ks < nk; ++ks) {
    asm volatile("s_waitcnt vmcnt(0)" ::: "memory");
    __syncthreads();
    if (ks + 1 < nk) GLDS_STAGE16((ks + 1) & 1, (ks + 1) << 6);
    const char* sb = lds + (ks & 1) * STAGE_BYTES;
#pragma unroll
    for (int k2 = 0; k2 < 2; ++k2) {
      bf16x8 af[8], bf[4];
#pragma unroll
      for (int m = 0; m < 8; ++m) af[m] = *(const bf16x8*)(sb + woff + m * 2048 + k2 * 1024);
#pragma unroll
      for (int n = 0; n < 4; ++n) bf[n] = *(const bf16x8*)(sb + xoff + n * 2048 + k2 * 1024);
#pragma unroll
      for (int m = 0; m < 8; ++m)
#pragma unroll
        for (int n = 0; n < 4; ++n) acc[m][n] = __builtin_amdgcn_mfma_f32_16x16x32_bf16(af[m], bf[n], acc[m][n], 0, 0, 0);
    }
  }
  __syncthreads();
#undef GLDS_STAGE16
}

DI bool tile_coord(int k, int NT, int& tm, int& tn) {
  if (gridDim.x & 7) {
    const int l = blockIdx.x + gridDim.x * k;
    if (l >= 64 * NT) return false;
    tm = l / NT; tn = l - tm * NT;
    return true;
  }
  const int xcd = blockIdx.x & 7, j = blockIdx.x >> 3, nper = gridDim.x >> 3;
  const int l = j + nper * k;
  if (l >= 8 * NT) return false;
  tm = xcd * 8 + (l & 7); tn = l >> 3;
  return true;
}

DI void st4(bf16_t* p, float a, float b, float c, float d) {
  uint2 v; v.x = pack2(a, b); v.y = pack2(c, d);
  *(uint2*)p = v;
}

DI int dest_row(int mode, int n, int Nh) {
  if (mode == 0) return n;
  if (mode == 1) {
    if (n < 640) return n;
    if (n < 672) return 3200 + (n - 640);
    return n - 32;
  }
  const int m = n < Nh ? n : n - Nh;
  if (mode == 3) { const int b16 = (m >> 4) * 32 + (m & 15); return n < Nh ? b16 : b16 + 16; }
  const int base = (m >> 5) * 64 + (m & 31);
  return n < Nh ? base : base + 32;
}

DI void transpose_unit(const float* __restrict__ W, int K, int N, int kt, int nt, bf16_t* __restrict__ out, int mode, int Nh,
                       const float* __restrict__ kscale, float* lds) {
  const int tid = otid();
  const int k0 = kt * 64, n0 = nt * 256;
  const int c4 = tid & 63, rb = tid >> 6;
  float4 v[8];
#pragma unroll
  for (int i = 0; i < 8; ++i) {
    const int k = rb + 8 * i;
    const int n = n0 + c4 * 4;
    v[i] = make_float4(0.f, 0.f, 0.f, 0.f);
    if (n < N) v[i] = *(const float4*)(W + (size_t)(k0 + k) * N + n);
  }
#pragma unroll
  for (int i = 0; i < 8; ++i) {
    const int k = rb + 8 * i;
    if (kscale) { const float sc = kscale[k0 + k]; v[i].x *= sc; v[i].y *= sc; v[i].z *= sc; v[i].w *= sc; }
    *(float4*)(lds + k * 260 + c4 * 4) = v[i];
  }
  __syncthreads();
#pragma unroll
  for (int i = 0; i < 4; ++i) {
    const int id = tid + NTHR * i;
    const int nl = id & 255, c = id >> 8;
    const int n = n0 + nl;
    if (n < N) {
      float t[8];
#pragma unroll
      for (int j = 0; j < 8; ++j) t[j] = lds[(c * 8 + j) * 260 + nl];
      uint4 o; o.x = pack2(t[0], t[1]); o.y = pack2(t[2], t[3]); o.z = pack2(t[4], t[5]); o.w = pack2(t[6], t[7]);
      *(uint4*)(out + (size_t)dest_row(mode, n, Nh) * K + k0 + c * 8) = o;
    }
  }
  __syncthreads();
}

DI void ada_unit(KP p, int j, float* lds) {
  const int tid = otid();
  float* sc = lds;
  float* red = lds + 4096;
  for (int i = tid; i < 4096; i += NTHR) { const float v = p->c[i]; sc[i] = v * sigm(v); }
  __syncthreads();
  const int cg4 = tid & 15, kg = tid >> 4;
  const int n = j * 64 + cg4 * 4;
  float acc[4][4];
#pragma unroll
  for (int b = 0; b < 4; ++b)
#pragma unroll
    for (int c = 0; c < 4; ++c) acc[b][c] = 0.f;
  const float* w = p->w_ada + (size_t)(kg * 32) * 6144 + n;
#pragma unroll 16
  for (int k = 0; k < 32; ++k) {
    const float4 wv = *(const float4*)(w + (size_t)k * 6144);
    const int kk = kg * 32 + k;
#pragma unroll
    for (int b = 0; b < 4; ++b) {
      const float sv = sc[b * 1024 + kk];
      acc[b][0] += sv * wv.x; acc[b][1] += sv * wv.y; acc[b][2] += sv * wv.z; acc[b][3] += sv * wv.w;
    }
  }
#pragma unroll
  for (int b = 0; b < 4; ++b) *(float4*)(red + (kg * 4 + b) * 64 + cg4 * 4) = make_float4(acc[b][0], acc[b][1], acc[b][2], acc[b][3]);
  __syncthreads();
  if (tid < 256) {
    const int b = tid >> 6, col = tid & 63;
    float s = 0.f;
#pragma unroll 8
    for (int g = 0; g < 32; ++g) s += red[(g * 4 + b) * 64 + col];
    float* ada = (float*)(ows(p) + OFF_ADA);
    ada[b * 6144 + j * 64 + col] = s + p->b_ada[j * 64 + col];
  }
  __syncthreads();
}

DI void s5param_unit(KP p, int dg) {
  const int tid = otid();
  const int pi = tid & 63, qtr = tid >> 6;
  const float lr = fminf(p->lam_re[dg * 64 + pi], -1e-4f);
  const float li = p->lam_im[dg * 64 + pi];
  const float dt = expf(p->log_dt[dg]);
  const float mag = expf(lr * dt);
  float sn_, cs_; sincosf(li * dt, &sn_, &cs_);
  const float ar = mag * cs_, ai = mag * sn_;
  const float nr = ar - 1.f, ni = ai;
  const float den = lr * lr + li * li;
  const float fre = (nr * lr + ni * li) / den, fim = (ni * lr - nr * li) / den;
  if (qtr == 0) {
    float2* A = (float2*)(ows(p) + OFF_SA);
    float2* AL = (float2*)(ows(p) + OFF_SAL);
    A[dg * 64 + pi] = make_float2(ar, ai);
    float pr = ar, pim = ai;
#pragma unroll
    for (int s = 0; s < 6; ++s) { const float t = pr * pr - pim * pim; pim = (pr + pr) * pim; pr = t; }
    AL[dg * 64 + pi] = make_float2(pr, pim);
  }
  char* wsl = ows(p);
  bf16_t* BBT = (bf16_t*)(wsl + OFF_BBT);
  bf16_t* CMT = (bf16_t*)(wsl + OFF_CMT);
#pragma unroll
  for (int q = 0; q < 2; ++q) {
    const int ch = qtr * 2 + q;
    const float bre = p->b_re[(size_t)(dg * 64 + pi) * 16 + ch], bim = p->b_im[(size_t)(dg * 64 + pi) * 16 + ch];
    BBT[(size_t)(dg * 128 + pi) * 16 + ch] = f2bf(fre * bre - fim * bim);
    BBT[(size_t)(dg * 128 + 64 + pi) * 16 + ch] = f2bf(fre * bim + fim * bre);
    const float cre = p->c_re[(size_t)(dg * 16 + ch) * 64 + pi], cim = p->c_im[(size_t)(dg * 16 + ch) * 64 + pi];
    CMT[(size_t)(dg * 16 + ch) * 128 + 2 * pi] = f2bf(cre);
    CMT[(size_t)(dg * 16 + ch) * 128 + 2 * pi + 1] = f2bf(-cim);
  }
}

DI float wave_sum(float v) {
#pragma unroll
  for (int o = 32; o >= 1; o >>= 1) v += __shfl_xor(v, o);
  return v;
}

DI void phase0(KP p, char* lds) {
  constexpr int U_WIN = 16 * 13, U_WUQ = 6 * 3, U_WUK = 4 * 2, U_WUV = 4 * 2, U_WO = 8 * 4, U_WGLU = 8 * 8, U_WMIX = 16 * 4, U_WFI = 16 * 22, U_WFO = 44 * 4;
  constexpr int B1 = U_WIN, B2 = B1 + U_WUQ, B3 = B2 + U_WUK, B4 = B3 + U_WUV, B5 = B4 + U_WO, B6 = B5 + U_WGLU, B7 = B6 + U_WMIX, B8 = B7 + U_WFI, B9 = B8 + U_WFO;
  constexpr int B10 = B9 + 96, B11 = B10 + 64, B12 = B11 + 2;
  char* ws = ows(p);
  for (int u0 = blockIdx.x; u0 < B12 - (B9 - B7); u0 += gridDim.x) {
    const int u = u0 < B7 ? u0 : u0 + (B9 - B7);
    if (u < B1) { const int v = u; transpose_unit(p->w_in, 1024, 3232, v / 13, v % 13, (bf16_t*)(ws + OFF_WIN), 1, 0, nullptr, (float*)lds); }
    else if (u < B2) { const int v = u - B1; transpose_unit(p->w_uq, 384, 768, v / 3, v % 3, (bf16_t*)(ws + OFF_WUQ), 0, 0, p->g_q, (float*)lds); }
    else if (u < B3) { const int v = u - B2; transpose_unit(p->w_uk, 256, 512, v / 2, v % 2, (bf16_t*)(ws + OFF_WUKV), 0, 0, p->g_kv, (float*)lds); }
    else if (u < B4) { const int v = u - B3; transpose_unit(p->w_uv, 256, 512, v / 2, v % 2, (bf16_t*)(ws + OFF_WUKV) + (size_t)512 * 256, 0, 0, p->g_kv, (float*)lds); }
    else if (u < B5) { const int v = u - B4; transpose_unit(p->w_o, 512, 1024, v / 4, v % 4, (bf16_t*)(ws + OFF_WO), 0, 0, nullptr, (float*)lds); }
    else if (u < B6) { const int v = u - B5; transpose_unit(p->w_glu, 512, 2048, v / 8, v % 8, (bf16_t*)(ws + OFF_WGLU), 3, 1024, nullptr, (float*)lds); }
    else if (u < B7) { const int v = u - B6; transpose_unit(p->w_mix, 1024, 1024, v / 4, v % 4, (bf16_t*)(ws + OFF_WMIX), 0, 0, nullptr, (float*)lds); }
    else if (u < B8) { const int v = u - B7; transpose_unit(p->w_ffn_in, 1024, 5632, v / 22, v % 22, (bf16_t*)(ws + OFF_WFI), 3, 2816, nullptr, (float*)lds); }
    else if (u < B9) { const int v = u - B8; transpose_unit(p->w_ffn_out, 2816, 1024, v / 4, v % 4, (bf16_t*)(ws + OFF_WFO), 0, 0, nullptr, (float*)lds); }
    else if (u < B10) { ada_unit(p, u - B9, (float*)lds); }
    else if (u < B11) { s5param_unit(p, u - B10); }
    else if (u == B11) {
      float* z = (float*)(ws + OFF_SSQ);
      for (int i = otid(); i < 4 * 16384; i += NTHR) z[i] = 0.f;
    } else {
      uint4* z = (uint4*)(ws + OFF_WIN + (size_t)3232 * 1024 * 2);
      unsigned z0_ = 0u; asm volatile("" : "+v"(z0_));
      const uint4 zz = make_uint4(z0_, z0_, z0_, z0_);
      for (int i = otid(); i < 96 * 1024 * 2 / 16; i += NTHR) z[i] = zz;
    }
  }
}

DI void phase0_deferred(KP p, char* lds, int rank, int stride) {
  constexpr int U_WFI = 16 * 22, U_WFO = 44 * 4;
  char* ws = ows(p);
  for (int v0 = rank; v0 < U_WFI + U_WFO; v0 += stride) {
    if (v0 < U_WFI) { const int v = v0; transpose_unit(p->w_ffn_in, 1024, 5632, v / 22, v % 22, (bf16_t*)(ws + OFF_WFI), 3, 2816, nullptr, (float*)lds); }
    else { const int v = v0 - U_WFI; transpose_unit(p->w_ffn_out, 2816, 1024, v / 4, v % 4, (bf16_t*)(ws + OFF_WFO), 0, 0, nullptr, (float*)lds); }
  }
}

DI void phase1(KP p) {
  const int tid_ = otid(); const int lane = tid_ & 63, wave = tid_ >> 6;
  char* wsl = ows(p);
  const float* ada = (const float*)(wsl + OFF_ADA);
  bf16_t* H = (bf16_t*)(wsl + OFF_H);
  const int rstep = gridDim.x * NWAVE;
  float4 nx[4];
  {
    const int row0 = blockIdx.x * NWAVE + wave;
    if (row0 < T) {
#pragma unroll
      for (int i = 0; i < 4; ++i) nx[i] = ((const float4*)(p->x + (size_t)row0 * D))[i * 64 + lane];
    }
  }
  for (int row = blockIdx.x * NWAVE + wave; row < T; row += rstep) {
    const int b = row >> 12;
    float4 v[4];
    float ss = 0.f;
#pragma unroll
    for (int i = 0; i < 4; ++i) v[i] = nx[i];
    if (row + rstep < T) {
#pragma unroll
      for (int i = 0; i < 4; ++i) nx[i] = ((const float4*)(p->x + (size_t)(row + rstep) * D))[i * 64 + lane];
    }
#pragma unroll
    for (int i = 0; i < 4; ++i) ss += v[i].x * v[i].x + v[i].y * v[i].y + v[i].z * v[i].z + v[i].w * v[i].w;
    ss = wave_sum(ss);
    const float rstd = rsqrtf(ss * (1.f / 1024.f) + 1e-6f);
    const float* sh = ada + b * 6144, * sc = ada + b * 6144 + 1024;
#pragma unroll
    for (int i = 0; i < 4; ++i) {
      const int col = (i * 64 + lane) * 4;
      const float4 g = *(const float4*)(p->g_pre_mix + col);
      const float4 s1 = *(const float4*)(sc + col);
      const float4 s0 = *(const float4*)(sh + col);
      st4(H + (size_t)row * D + col, v[i].x * rstd * g.x * (1.f + s1.x) + s0.x, v[i].y * rstd * g.y * (1.f + s1.y) + s0.y,
          v[i].z * rstd * g.z * (1.f + s1.z) + s0.z, v[i].w * rstd * g.w * (1.f + s1.w) + s0.w);
    }
  }
}

DI void rope_angles(int pos, int d, float& cs, float& sn) {
  const float c = __builtin_amdgcn_exp2f(-(float)d * 0.8304820237218405f) * 0.15915494309189535f;
  const float t = __builtin_amdgcn_fractf((float)pos * c);
  sn = __builtin_amdgcn_sinf(t); cs = __builtin_amdgcn_cosf(t);
}

DI void gates_epilogue16(const f32x4v (&acc)[8][4], char* ws, int tokb, int fo, int fr, int fq) {
  bf16_t* dst = (bf16_t*)(ws + OFF_GATES);
#pragma unroll
  for (int n = 0; n < 4; ++n)
#pragma unroll
    for (int m = 0; m < 8; ++m)
      st4(dst + (size_t)(tokb + n * 16 + fr) * 2048 + fo + m * 16 + 4 * fq, sigm(acc[m][n][0]), sigm(acc[m][n][1]), sigm(acc[m][n][2]), sigm(acc[m][n][3]));
}

DI void phase2(KP p, char* lds) {
  const int tid = otid(), lane = tid & 63, wave = tid >> 6;
  const int fr = lane & 15, fq = lane >> 4, wr = wave >> 2, wc = wave & 3;
  char* ws = ows(p);
  const bf16_t* H = (const bf16_t*)(ws + OFF_H);
  const bf16_t* W = (const bf16_t*)(ws + OFF_WIN);
  for (int k_ = 0;; ++k_) {
    int tn, tm; if (!tile_coord(k_, 12, tm, tn)) break;
    if (tn == 11) tn = 12;
    f32x4v acc[8][4];
    gemm_tile16(H + (size_t)tm * 256 * 1024, 1024, W + (size_t)tn * 256 * 1024, 1024, 1024, acc, lds);
    const int tokb = tm * 256 + wc * 64;
    const int hidx = tn * 2 + wr;
    if (hidx < 5) {
      bf16_t* dst; int ld, fo; float* ssa;
      if (hidx < 3) { dst = (bf16_t*)(ws + OFF_QLAT); ld = 384; fo = hidx * 128; ssa = (float*)(ws + OFF_SSQ); }
      else { dst = (bf16_t*)(ws + OFF_KVLAT); ld = 256; fo = (hidx - 3) * 128; ssa = (float*)(ws + OFF_SSKV); }
#pragma unroll
      for (int n = 0; n < 4; ++n) {
        const int tok = tokb + n * 16 + fr;
        float ss = 0.f;
#pragma unroll
        for (int m = 0; m < 8; ++m) {
          const float a = acc[m][n][0], b = acc[m][n][1], c = acc[m][n][2], d = acc[m][n][3];
          ss += a * a + b * b + c * c + d * d;
          st4(dst + (size_t)tok * ld + fo + m * 16 + 4 * fq, a, b, c, d);
        }
        ss += __shfl_xor(ss, 16);
        ss += __shfl_xor(ss, 32);
        if (fq == 0) atomicAdd(ssa + tok, ss);
      }
    } else if (hidx < 9) {
      bf16_t* dst = (bf16_t*)(ws + OFF_U);
      const int fo = (hidx - 5) * 128;
#pragma unroll
      for (int n = 0; n < 4; ++n)
#pragma unroll
        for (int m = 0; m < 8; ++m)
          st4(dst + (size_t)(tokb + n * 16 + fr) * 512 + fo + m * 16 + 4 * fq, acc[m][n][0], acc[m][n][1], acc[m][n][2], acc[m][n][3]);
    } else if (hidx < 25) {
      gates_epilogue16(acc, ws, tokb, (hidx - 9) * 128, fr, fq);
    } else {
      bf16_t* dst = (bf16_t*)(ws + OFF_KROPE);
#pragma unroll
      for (int n = 0; n < 4; ++n) {
        const int tok = tokb + n * 16 + fr;
        const int pos = p->pos[tok];
        float o0[4], o1[4];
#pragma unroll
        for (int j = 0; j < 4; ++j) {
          float cs, sn; rope_angles(pos, 4 * fq + j, cs, sn);
          const float x1 = acc[0][n][j], x2 = acc[1][n][j];
          o0[j] = x1 * cs - x2 * sn; o1[j] = x2 * cs + x1 * sn;
        }
        st4(dst + (size_t)tok * 32 + 4 * fq, o0[0], o0[1], o0[2], o0[3]);
        st4(dst + (size_t)tok * 32 + 16 + 4 * fq, o1[0], o1[1], o1[2], o1[3]);
      }
    }
  }
}

template <bool PASS2>
DI void s5_wave_item(KP p, int w, char* lds_wave) {
  const int lane = otid() & 63;
  const int r = lane & 31, hh = lane >> 5;
  const int k = w & 31, g = (w >> 5) & 31, b = w >> 10;
  char* ws = ows(p);
  const bf16_t* U = (const bf16_t*)(ws + OFF_U);
  const float2* SA = (const float2*)(ws + OFF_SA);
  const float2* SAL = (const float2*)(ws + OFF_SAL);
  const bf16_t* BBT = (const bf16_t*)(ws + OFF_BBT);
  const bf16_t* CMT = (const bf16_t*)(ws + OFF_CMT);
  float2* E = (float2*)(ws + OFF_E);
  const int my_chunk = 2 * k + hh;
  const int a_chunk = 2 * k + ((r >> 2) & 1);
  const int a_idx = (r & 3) + 4 * (r >> 3);
  const bf16_t* ua = U + ((size_t)(b * SEQ + a_chunk * 64 + a_idx)) * 512 + g * 16 + 8 * hh;
  bf16x8 af_nxt = *(const bf16x8*)ua;
  char* Hs = lds_wave;
  float* Yf = (float*)(lds_wave + 8704);
  f32x16 zero;
#pragma unroll
  for (int i = 0; i < 16; ++i) zero[i] = 0.f;
  const int yfr = lane & 15, yfq = lane >> 4;
  const float dsk = PASS2 ? p->ssm_d[g * 16 + yfr] : 0.f;

#pragma unroll 1
  for (int d = 0; d < 2; ++d) {
    const int dg = d * 32 + g;
    const float2 a0 = SA[dg * 64 + r], a1 = SA[dg * 64 + 32 + r];
    bf16x8 bfr[4];
#pragma unroll
    for (int q = 0; q < 4; ++q) bfr[q] = *(const bf16x8*)(BBT + (size_t)(dg * 128 + 32 * q + r) * 16 + 8 * hh);
    float h0r = 0.f, h0i = 0.f, h1r = 0.f, h1i = 0.f;
    bf16x8 cfr[4];
    if (PASS2) {
      const bf16_t* cptr = CMT + (size_t)(dg * 16 + yfr) * 128 + 8 * yfq;
#pragma unroll
      for (int s = 0; s < 4; ++s) cfr[s] = *(const bf16x8*)(cptr + 32 * s);
      const float2* Sb = (const float2*)(ws + OFF_S) + ((size_t)((d * 4 + b) * 32 + g) * 64 + my_chunk) * 64;
      const float2 s0 = Sb[r], s1 = Sb[32 + r];
      h0r = s0.x; h0i = s0.y; h1r = s1.x; h1i = s1.y;
    }
#pragma unroll 1
    for (int sbi = 0; sbi < 4; ++sbi) {
      const int sbx = (d == 0) ? sbi : 3 - sbi;
      const bf16x8 af = af_nxt;
      {
        const int qn = d * 4 + sbi + 1;
        const int sbn = (qn < 4 ? qn : 7 - qn) & 3;
        af_nxt = *(const bf16x8*)(ua + (size_t)(sbn * 16) * 512);
      }
#pragma unroll
      for (int half = 0; half < 2; ++half) {
        f32x16 XR = MFMA(af, bfr[half], zero), XI = MFMA(af, bfr[2 + half], zero);
        const float2 aa = half ? a1 : a0;
        float hr = half ? h1r : h0r, hi = half ? h1i : h0i;
        if (d == 0) {
#pragma unroll
          for (int i = 0; i < 16; ++i) {
            const float t0 = aa.x * hr - aa.y * hi + XR[i]; const float t1 = aa.x * hi + aa.y * hr + XI[i]; hr = t0; hi = t1; XR[i] = t0; XI[i] = t1;
          }
        } else {
#pragma unroll
          for (int i = 15; i >= 0; --i) {
            const float t0 = aa.x * hr - aa.y * hi + XR[i]; const float t1 = aa.x * hi + aa.y * hr + XI[i]; hr = t0; hi = t1; XR[i] = t0; XI[i] = t1;
          }
        }
        if (half) { h1r = hr; h1i = hi; } else { h0r = hr; h0i = hi; }
        if (PASS2) {
#pragma unroll
          for (int i = 0; i < 16; ++i) *(unsigned*)(Hs + crow(i, hh) * 272 + 4 * (r + 32 * half)) = pack2(XR[i], XI[i]);
        }
      }
      if (PASS2) {
        const int sb = sbx;
        f32x4v yv[2];
        yv[0] = (f32x4v){0.f, 0.f, 0.f, 0.f}; yv[1] = yv[0];
#pragma unroll
        for (int s4 = 0; s4 < 4; ++s4)
#pragma unroll
          for (int mt = 0; mt < 2; ++mt) {
            const bf16x8 hf = *(const bf16x8*)(Hs + (mt * 16 + yfr) * 272 + (32 * s4 + 8 * yfq) * 2);
            yv[mt] = __builtin_amdgcn_mfma_f32_16x16x32_bf16(hf, cfr[s4], yv[mt], 0, 0, 0);
          }
        const int yh = yfq & 1;
        if (d == 0) {
#pragma unroll
          for (int mt = 0; mt < 2; ++mt)
#pragma unroll
            for (int j = 0; j < 4; ++j) {
              const int idx = j + 4 * (2 * mt + (yfq >> 1));
              Yf[(yh * 64 + sb * 16 + idx) * 16 + yfr] = yv[mt][j];
            }
        } else {
          float uval[2][4];
#pragma unroll
          for (int mt = 0; mt < 2; ++mt)
#pragma unroll
            for (int j = 0; j < 4; ++j) {
              const int idx = j + 4 * (2 * mt + (yfq >> 1));
              const size_t tok = (size_t)b * SEQ + (2 * k + yh) * 64 + sb * 16 + idx;
              uval[mt][j] = bf2f(U[tok * 512 + g * 16 + yfr]);
            }
#pragma unroll
          for (int mt = 0; mt < 2; ++mt)
#pragma unroll
            for (int j = 0; j < 4; ++j) {
              const int idx = j + 4 * (2 * mt + (yfq >> 1));
              const float tot = yv[mt][j] + Yf[(yh * 64 + sb * 16 + idx) * 16 + yfr] + dsk * uval[mt][j];
              *(bf16_t*)(Hs + ((yh * 16 + idx) * 16 + yfr) * 2) = f2bf(gelu_tanh(tot));
            }
          {
            const int row = lane >> 1, half = lane & 1;
            const uint4 val = *(const uint4*)(Hs + row * 32 + half * 16);
            const size_t tok = (size_t)b * SEQ + (2 * k + (row >> 4)) * 64 + sb * 16 + (row & 15);
            *(uint4*)((bf16_t*)(ws + OFF_YG) + tok * 512 + g * 16 + half * 8) = val;
          }
        }
      }
    }
    if (!PASS2) {
      float2* Eb = E + ((size_t)((d * 4 + b) * 32 + g) * 64 + my_chunk) * 64;
      Eb[r] = make_float2(h0r, h0i);
      Eb[32 + r] = make_float2(h1r, h1i);
    }
  }
}

DI void phase3(KP p, char* lds) {
  const int tid = otid(), lane = tid & 63, wave = tid >> 6;
  const int r = lane & 31, hh = lane >> 5, wn = wave & 1, wm = wave >> 1;
  char* ws = ows(p);
  constexpr int NS = 512;
  for (int v = blockIdx.x; v < NS; v += gridDim.x) s5_wave_item<false>(p, v * NWAVE + wave, lds + wave * S5_WAVE_LDS);
  __syncthreads();
  {
    const bool generic = (gridDim.x & 7) != 0 || (gridDim.x >> 3) <= 8;
    const int xcd = blockIdx.x & 7, j = blockIdx.x >> 3, nper = generic ? 1 : (int)(gridDim.x >> 3);
    const int jj = generic ? 0 : (j + nper - (24 % nper)) % nper;
    const int l0 = generic ? (int)blockIdx.x : jj, lstep = generic ? (int)gridDim.x : nper, lend = generic ? 64 : 8;
    for (int l = l0; l < lend; l += lstep) {
      const int tm = generic ? l : xcd * 8 + l;
      f32x4v acc[8][4];
      gemm_tile16((const bf16_t*)(ws + OFF_H) + (size_t)tm * 256 * 1024, 1024, (const bf16_t*)(ws + OFF_WIN) + (size_t)11 * 256 * 1024, 1024, 1024, acc, lds);
      gates_epilogue16(acc, ws, tm * 256 + (wave & 3) * 64, (22 + (wave >> 2) - 9) * 128, lane & 15, lane >> 4);
    }
    if (generic) phase0_deferred(p, lds, blockIdx.x, gridDim.x);
    else if (jj >= 8) phase0_deferred(p, lds, xcd * (nper - 8) + (jj - 8), 8 * (nper - 8));
  }
  {
    const int fr = lane & 15, fq = lane >> 4, wr = wave >> 2, wc = wave & 3;
    for (int k_ = 0;; ++k_) {
      int tn, tm; if (!tile_coord(k_, 3, tm, tn)) break;
      f32x4v acc[8][4];
      float ssq_pre[4]; int pos_pre[4];
#pragma unroll
      for (int n = 0; n < 4; ++n) { const int tok_ = tm * 256 + wc * 64 + n * 16 + fr; ssq_pre[n] = ((const float*)(ws + OFF_SSQ))[tok_]; pos_pre[n] = p->pos[tok_]; }
      gemm_tile16((const bf16_t*)(ws + OFF_QLAT) + (size_t)tm * 256 * 384, 384, (const bf16_t*)(ws + OFF_WUQ) + (size_t)tn * 256 * 384, 384, 384, acc, lds);
      bf16_t* Q = (bf16_t*)(ws + OFF_Q);
      const float qscale = 0.10206207261596575f * 1.4426950408889634f;
#pragma unroll
      for (int n = 0; n < 4; ++n) {
        const int tok = tm * 256 + wc * 64 + n * 16 + fr;
        const int b = tok >> 12, sq = tok & 4095;
        const float sc = rsqrtf(ssq_pre[n] * (1.f / 384.f) + 1e-6f) * qscale;
        const int pos = pos_pre[n];
#pragma unroll
        for (int mp = 0; mp < 4; ++mp) {
          const int sidx = tn * 8 + wr * 4 + mp;
          const int head = sidx / 3, part = sidx - head * 3;
          float o0[4], o1[4];
          if (part == 2) {
#pragma unroll
            for (int j = 0; j < 4; ++j) {
              float cs, sn; rope_angles(pos, 4 * fq + j, cs, sn);
              const float x1 = acc[2 * mp][n][j] * sc, x2 = acc[2 * mp + 1][n][j] * sc;
              o0[j] = x1 * cs - x2 * sn; o1[j] = x2 * cs + x1 * sn;
            }
          } else {
#pragma unroll
            for (int j = 0; j < 4; ++j) { o0[j] = acc[2 * mp][n][j] * sc; o1[j] = acc[2 * mp + 1][n][j] * sc; }
          }
          bf16_t* dst = Q + ((size_t)((b * 8 + head) * SEQ + sq)) * 96 + part * 32 + 4 * fq;
          st4(dst, o0[0], o0[1], o0[2], o0[3]);
          st4(dst + 16, o1[0], o1[1], o1[2], o1[3]);
        }
      }
    }
    for (int k_ = 0;; ++k_) {
      int tn, tm; if (!tile_coord(k_, 4, tm, tn)) break;
      f32x4v acc[8][4];
      const float* sskv = (const float*)(ws + OFF_SSKV);
      if (tn < 2) {
        gemm_tile16((const bf16_t*)(ws + OFF_KVLAT) + (size_t)tm * 256 * 256, 256, (const bf16_t*)(ws + OFF_WUKV) + (size_t)tn * 256 * 256, 256, 256, acc, lds);
#pragma unroll
        for (int n = 0; n < 4; ++n) {
          const int tok = tm * 256 + wc * 64 + n * 16 + fr;
          const int b = tok >> 12, sq = tok & 4095;
          const float sc = rsqrtf(sskv[tok] * (1.f / 256.f) + 1e-6f);
#pragma unroll
          for (int m = 0; m < 8; ++m) {
            const int f = tn * 256 + wr * 128 + m * 16 + 4 * fq;
            const int head = f >> 6, d0 = f & 63;
            st4((bf16_t*)(ws + OFF_KN) + ((size_t)((b * 8 + head) * SEQ + sq)) * 64 + d0, acc[m][n][0] * sc, acc[m][n][1] * sc, acc[m][n][2] * sc, acc[m][n][3] * sc);
          }
        }
      } else {
        gemm_tile16((const bf16_t*)(ws + OFF_WUKV) + (size_t)tn * 256 * 256, 256, (const bf16_t*)(ws + OFF_KVLAT) + (size_t)tm * 256 * 256, 256, 256, acc, lds);
#pragma unroll
        for (int n = 0; n < 4; ++n) {
          const int f = (tn - 2) * 256 + wc * 64 + n * 16 + fr;
          const int head = f >> 6, dv = f & 63;
#pragma unroll
          for (int m = 0; m < 8; ++m) {
            const int tok = tm * 256 + wr * 128 + m * 16 + 4 * fq;
            const int b = tok >> 12, sq = tok & 4095;
            const float4 ssv = *(const float4*)(sskv + tok);
            st4((bf16_t*)(ws + OFF_VT) + ((size_t)((b * 8 + head) * 64 + dv)) * SEQ + sq,
                acc[m][n][0] * rsqrtf(ssv.x * (1.f / 256.f) + 1e-6f), acc[m][n][1] * rsqrtf(ssv.y * (1.f / 256.f) + 1e-6f),
                acc[m][n][2] * rsqrtf(ssv.z * (1.f / 256.f) + 1e-6f), acc[m][n][3] * rsqrtf(ssv.w * (1.f / 256.f) + 1e-6f));
          }
        }
      }
    }
  }
}

template <int NQ>
DI void attn_item(KP p, int item, char* lds) {
  const int tid = otid(), lane = tid & 63, wave = tid >> 6;
  const int r = lane & 31, hh = lane >> 5;
  constexpr int NQB = 16 / NQ, LQ = (NQ == 2) ? 3 : 4;
  const int qb = item & (NQB - 1), h = (item >> LQ) & 7, b = item >> (LQ + 3);
  char* ws = ows(p);
  const bf16_t* Q = (const bf16_t*)(ws + OFF_Q) + ((size_t)(b * 8 + h) * SEQ) * 96;
  const bf16_t* Kn = (const bf16_t*)(ws + OFF_KN) + ((size_t)(b * 8 + h) * SEQ) * 64;
  const bf16_t* Kr = (const bf16_t*)(ws + OFF_KROPE) + (size_t)b * SEQ * 32;
  const bf16_t* Vt = (const bf16_t*)(ws + OFF_VT) + ((size_t)(b * 8 + h) * 64) * SEQ;
  const int q0 = qb * (256 * NQ) + wave * (32 * NQ) + r;
  bf16x8 qf[NQ][6];
#pragma unroll
  for (int u = 0; u < NQ; ++u)
#pragma unroll
    for (int ks = 0; ks < 6; ++ks) qf[u][ks] = *(const bf16x8*)(Q + (size_t)(q0 + 32 * u) * 96 + ks * 16 + hh * 8);
  constexpr int ST = 43520, VOFF = 26624, VRS = 264;
  uint4 kreg0, kreg1, kreg2, vreg0, vreg1;
  const int krow_ = tid >> 3, kc8 = tid & 7;
  const int rrow = tid >> 2, rc4 = tid & 3;
  const bf16_t* kp0 = Kn + (size_t)krow_ * 64 + kc8 * 8;
  const bf16_t* kp2 = Kr + (size_t)rrow * 32 + rc4 * 8;
  const bf16_t* vp0 = Vt + (size_t)krow_ * SEQ + kc8 * 8;
  char* const kw0 = lds + krow_ * 208 + kc8 * 16;
  char* const kw2 = lds + rrow * 208 + 128 + rc4 * 16;
  char* const vw0 = lds + VOFF + krow_ * VRS + kc8 * 16;
#define ATT_GLOAD(k0) { kreg0 = *(const uint4*)(kp0 + (size_t)(k0) * 64); kreg1 = *(const uint4*)(kp0 + (size_t)((k0) + 64) * 64); kreg2 = *(const uint4*)(kp2 + (size_t)(k0) * 32); \
    vreg0 = *(const uint4*)(vp0 + (k0)); vreg1 = *(const uint4*)(vp0 + (k0) + 64); }
#define ATT_SWRITE(st) { const int so = (st) * ST; *(uint4*)(kw0 + so) = kreg0; *(uint4*)(kw0 + so + 64 * 208) = kreg1; *(uint4*)(kw2 + so) = kreg2; \
    *(uint2*)(vw0 + so) = make_uint2(vreg0.x, vreg0.y); *(uint2*)(vw0 + so + 8) = make_uint2(vreg0.z, vreg0.w); \
    *(uint2*)(vw0 + so + 128) = make_uint2(vreg1.x, vreg1.y); *(uint2*)(vw0 + so + 136) = make_uint2(vreg1.z, vreg1.w); }
  f32x16 oacc[NQ][2];
  float m[NQ], lsum[NQ];
#pragma unroll
  for (int u = 0; u < NQ; ++u) {
    m[u] = -INFINITY; lsum[u] = 0.f;
#pragma unroll
    for (int i = 0; i < 16; ++i) { oacc[u][0][i] = 0.f; oacc[u][1][i] = 0.f; }
  }
  ATT_GLOAD(0); ATT_SWRITE(0); __syncthreads();
  constexpr int NT = SEQ / 128;
#pragma unroll 1
  for (int t = 0; t < NT; ++t) {
    const bool more = (t + 1 < NT);
    if (more) ATT_GLOAD((t + 1) * 128);
#pragma unroll 1
    for (int hf = 0; hf < 2; ++hf) {
      const char* base = lds + (t & 1) * ST + hf * (64 * 208);
      const char* vbase = lds + (t & 1) * ST + VOFF + hf * 128;
      f32x16 s[NQ][2];
#pragma unroll
      for (int kt = 0; kt < 2; ++kt) {
#pragma unroll
        for (int u = 0; u < NQ; ++u)
#pragma unroll
          for (int i = 0; i < 16; ++i) s[u][kt][i] = 0.f;
#pragma unroll
        for (int ks = 0; ks < 6; ++ks) {
          const bf16x8 kf = *(const bf16x8*)(base + (kt * 32 + r) * 208 + ks * 32 + hh * 16);
#pragma unroll
          for (int u = 0; u < NQ; ++u) s[u][kt] = MFMA(kf, qf[u][ks], s[u][kt]);
        }
      }
#pragma unroll
      for (int u = 0; u < NQ; ++u) {
        if (t == 0 && hf == 0) {
          float mx = s[u][0][0];
#pragma unroll
          for (int i = 1; i < 16; ++i) mx = fmaxf(mx, s[u][0][i]);
#pragma unroll
          for (int i = 0; i < 16; ++i) mx = fmaxf(mx, s[u][1][i]);
          const unsigned mu = __float_as_uint(mx);
          const auto sw = __builtin_amdgcn_permlane32_swap(mu, mu, false, false);
          m[u] = fmaxf(__uint_as_float(sw[0]), __uint_as_float(sw[1]));
        }
        const float mref = m[u];
        float ps = 0.f;
#pragma unroll
        for (int kt = 0; kt < 2; ++kt)
#pragma unroll
          for (int i = 0; i < 16; ++i) { const float pv = __builtin_amdgcn_exp2f(s[u][kt][i] - mref); s[u][kt][i] = pv; ps += pv; }
        if (__any(ps > 4096.f)) {
          float pm = s[u][0][0];
#pragma unroll
          for (int i = 1; i < 16; ++i) pm = fmaxf(pm, s[u][0][i]);
#pragma unroll
          for (int i = 0; i < 16; ++i) pm = fmaxf(pm, s[u][1][i]);
          const unsigned mu = __float_as_uint(pm);
          const auto sw = __builtin_amdgcn_permlane32_swap(mu, mu, false, false);
          pm = fmaxf(fmaxf(__uint_as_float(sw[0]), __uint_as_float(sw[1])), 1.f);
          const float alpha = __builtin_amdgcn_rcpf(pm);
          m[u] = mref + __builtin_amdgcn_logf(pm);
          lsum[u] *= alpha; ps *= alpha;
#pragma unroll
          for (int i = 0; i < 16; ++i) { oacc[u][0][i] *= alpha; oacc[u][1][i] *= alpha; s[u][0][i] *= alpha; s[u][1][i] *= alpha; }
        }
        lsum[u] += ps;
      }
#pragma unroll
      for (int kt = 0; kt < 2; ++kt)
#pragma unroll
        for (int s2 = 0; s2 < 2; ++s2) {
          bf16x8 pf[NQ];
#pragma unroll
          for (int u = 0; u < NQ; ++u) {
            u32x4 pu;
            pu.x = pack2(s[u][kt][8 * s2 + 0], s[u][kt][8 * s2 + 1]); pu.y = pack2(s[u][kt][8 * s2 + 2], s[u][kt][8 * s2 + 3]);
            pu.z = pack2(s[u][kt][8 * s2 + 4], s[u][kt][8 * s2 + 5]); pu.w = pack2(s[u][kt][8 * s2 + 6], s[u][kt][8 * s2 + 7]);
            pf[u] = __builtin_bit_cast(bf16x8, pu);
          }
#pragma unroll
          for (int dt = 0; dt < 2; ++dt) {
            const char* va = vbase + (dt * 32 + r) * VRS + (kt * 32 + 16 * s2 + 4 * hh) * 2;
            const uint2 v0 = *(const uint2*)va;
            const uint2 v1 = *(const uint2*)(va + 16);
            u32x4 vu; vu.x = v0.x; vu.y = v0.y; vu.z = v1.x; vu.w = v1.y;
            const bf16x8 vf = __builtin_bit_cast(bf16x8, vu);
#pragma unroll
            for (int u = 0; u < NQ; ++u) oacc[u][dt] = MFMA(vf, pf[u], oacc[u][dt]);
          }
        }
    }
    if (more) ATT_SWRITE((t + 1) & 1);
    __syncthreads();
  }
#pragma unroll
  for (int u = 0; u < NQ; ++u) {
    const float l = lsum[u] + __shfl_xor(lsum[u], 32);
    const float inv = __builtin_amdgcn_rcpf(l);
    bf16_t* O = (bf16_t*)(ws + OFF_O) + ((size_t)(b * SEQ + q0 + 32 * u)) * 512 + h * 64 + 4 * hh;
#pragma unroll
    for (int dt = 0; dt < 2; ++dt)
#pragma unroll
      for (int qq = 0; qq < 4; ++qq)
        st4(O + dt * 32 + 8 * qq, oacc[u][dt][4 * qq] * inv, oacc[u][dt][4 * qq + 1] * inv, oacc[u][dt][4 * qq + 2] * inv, oacc[u][dt][4 * qq + 3] * inv);
  }
}

DI void phase_carry(KP p) {
  const int tid = otid(), lane = tid & 63, wave = tid >> 6;
  char* ws = ows(p);
  if (wave != 0) return;
  for (int u = blockIdx.x; u < 256; u += gridDim.x) {
    const int g = u & 31, d = u >> 7;
    const float2 aL = ((const float2*)(ws + OFF_SAL))[(d * 32 + g) * 64 + lane];
    const float2* Eb = (const float2*)(ws + OFF_E) + (size_t)u * 64 * 64;
    float2* Sb = (float2*)(ws + OFF_S) + (size_t)u * 64 * 64;
    float hr = 0.f, hi = 0.f;
#pragma unroll 1
    for (int j0 = 0; j0 < 64; j0 += 32) {
      float2 e[32];
#pragma unroll
      for (int q = 0; q < 32; ++q) { const int c = (d == 0) ? (j0 + q) : 63 - (j0 + q); e[q] = Eb[(size_t)c * 64 + lane]; }
#pragma unroll
      for (int q = 0; q < 32; ++q) {
        const int c = (d == 0) ? (j0 + q) : 63 - (j0 + q);
        Sb[(size_t)c * 64 + lane] = make_float2(hr, hi);
        const float t0 = aL.x * hr - aL.y * hi + e[q].x, t1 = aL.x * hi + aL.y * hr + e[q].y;
        hr = t0; hi = t1;
      }
    }
  }
}

DI void phase4(KP p, char* lds) {
  const int wave = otid() >> 6;
  for (int it = blockIdx.x; it < 512; it += gridDim.x) s5_wave_item<true>(p, it * NWAVE + wave, lds + wave * S5_WAVE_LDS);
  __syncthreads();
}

DI void phase5(KP p, char* lds) {
  for (int it = blockIdx.x; it < 512 / ATT_NQ; it += gridDim.x) attn_item<ATT_NQ>(p, it, lds);
  const int tid = otid(), lane = tid & 63, wave = tid >> 6;
  const int fr = lane & 15, fq = lane >> 4, wr = wave >> 2, wc = wave & 3;
  char* ws = ows(p);
  for (int k_ = 0;; ++k_) {
    int tn, tm; if (!tile_coord(k_, 8, tm, tn)) break;
    f32x4v acc[8][4];
    gemm_tile16((const bf16_t*)(ws + OFF_YG) + (size_t)tm * 256 * 512, 512, (const bf16_t*)(ws + OFF_WGLU) + (size_t)tn * 256 * 512, 512, 512, acc, lds);
    const bf16_t* G = (const bf16_t*)(ws + OFF_GATES);
    bf16_t* BB = (bf16_t*)(ws + OFF_BB);
#pragma unroll
    for (int n = 0; n < 4; ++n) {
      const int tok = tm * 256 + wc * 64 + n * 16 + fr;
#pragma unroll
      for (int pm = 0; pm < 4; ++pm) {
        const int f = tn * 128 + wr * 64 + pm * 16 + 4 * fq;
        const uint2 gb = *(const uint2*)(G + (size_t)tok * 2048 + 1024 + f);
        const float gbv[4] = {bflo(gb.x), bfhi(gb.x), bflo(gb.y), bfhi(gb.y)};
        float o[4];
#pragma unroll
        for (int j = 0; j < 4; ++j) o[j] = gbv[j] * acc[2 * pm][n][j] * sigm(acc[2 * pm + 1][n][j]);
        st4(BB + (size_t)tok * 1024 + f, o[0], o[1], o[2], o[3]);
      }
    }
  }
}

DI void phase6(KP p, char* lds) {
  const int tid = otid(), lane = tid & 63, wave = tid >> 6;
  const int fr = lane & 15, fq = lane >> 4, wr = wave >> 2, wc = wave & 3;
  char* ws = ows(p);
  for (int k_ = 0;; ++k_) {
    int tn, tm; if (!tile_coord(k_, 4, tm, tn)) break;
    f32x4v acc[8][4];
    gemm_tile16((const bf16_t*)(ws + OFF_O) + (size_t)tm * 256 * 512, 512, (const bf16_t*)(ws + OFF_WO) + (size_t)tn * 256 * 512, 512, 512, acc, lds);
    const bf16_t* G = (const bf16_t*)(ws + OFF_GATES);
    const bf16_t* BB = (const bf16_t*)(ws + OFF_BB);
    bf16_t* M = (bf16_t*)(ws + OFF_M);
#pragma unroll
    for (int n = 0; n < 4; ++n) {
      const int tok = tm * 256 + wc * 64 + n * 16 + fr;
#pragma unroll
      for (int m = 0; m < 8; ++m) {
        const int f = tn * 256 + wr * 128 + m * 16 + 4 * fq;
        const uint2 ga = *(const uint2*)(G + (size_t)tok * 2048 + f);
        const uint2 bb = *(const uint2*)(BB + (size_t)tok * 1024 + f);
        st4(M + (size_t)tok * 1024 + f, bflo(ga.x) * acc[m][n][0] + bflo(bb.x), bfhi(ga.x) * acc[m][n][1] + bfhi(bb.x),
            bflo(ga.y) * acc[m][n][2] + bflo(bb.y), bfhi(ga.y) * acc[m][n][3] + bfhi(bb.y));
      }
      asm volatile("" ::: "memory");
    }
  }
}

DI void phase_gemm_ss(KP p, char* lds, size_t offX, int K, size_t offW, size_t offOut, size_t offSS) {
  const int tid = otid(), lane = tid & 63, wave = tid >> 6;
  const int fr = lane & 15, fq = lane >> 4, wr = wave >> 2, wc = wave & 3;
  char* ws = ows(p);
  for (int k_ = 0;; ++k_) {
    int tn, tm; if (!tile_coord(k_, 4, tm, tn)) break;
    f32x4v acc[8][4];
    gemm_tile16((const bf16_t*)(ws + offX) + (size_t)tm * 256 * K, K, (const bf16_t*)(ws + offW) + (size_t)tn * 256 * K, K, K, acc, lds);
    bf16_t* dst = (bf16_t*)(ws + offOut);
    float* ssa = (float*)(ws + offSS);
#pragma unroll
    for (int n = 0; n < 4; ++n) {
      const int tok = tm * 256 + wc * 64 + n * 16 + fr;
      float ss = 0.f;
#pragma unroll
      for (int m = 0; m < 8; ++m) {
        const float a = acc[m][n][0], b = acc[m][n][1], c = acc[m][n][2], d = acc[m][n][3];
        ss += a * a + b * b + c * c + d * d;
        st4(dst + (size_t)tok * 1024 + tn * 256 + wr * 128 + m * 16 + 4 * fq, a, b, c, d);
      }
      ss += __shfl_xor(ss, 16);
      ss += __shfl_xor(ss, 32);
      if (fq == 0) atomicAdd(ssa + tok, ss);
    }
  }
}

DI void phase7(KP p) {
  const int tid_ = otid(); const int lane = tid_ & 63, wave = tid_ >> 6;
  char* wsl = ows(p);
  const float* ada = (const float*)(wsl + OFF_ADA);
  const bf16_t* MX = (const bf16_t*)(wsl + OFF_MIXED);
  const float* ssm = (const float*)(wsl + OFF_SSM);
  bf16_t* H = (bf16_t*)(wsl + OFF_H);
  const int rstep = gridDim.x * NWAVE;
  float4 nx[4]; uint2 nm[4];
  {
    const int row0 = blockIdx.x * NWAVE + wave;
    if (row0 < T) {
#pragma unroll
      for (int i = 0; i < 4; ++i) { const int col = (i * 64 + lane) * 4; nx[i] = *(const float4*)(p->x + (size_t)row0 * D + col); nm[i] = *(const uint2*)(MX + (size_t)row0 * D + col); }
    }
  }
  for (int row = blockIdx.x * NWAVE + wave; row < T; row += rstep) {
    const int b = row >> 12;
    const float rm = rsqrtf(ssm[row] * (1.f / 1024.f) + 1e-6f);
    const float* gt1 = ada + b * 6144 + 2048, * sh2 = ada + b * 6144 + 3072, * sc2 = ada + b * 6144 + 4096;
    float4 v[4], cx[4]; uint2 cm[4];
    float ss = 0.f;
#pragma unroll
    for (int i = 0; i < 4; ++i) { cx[i] = nx[i]; cm[i] = nm[i]; }
    if (row + rstep < T) {
#pragma unroll
      for (int i = 0; i < 4; ++i) { const int col = (i * 64 + lane) * 4; nx[i] = *(const float4*)(p->x + (size_t)(row + rstep) * D + col); nm[i] = *(const uint2*)(MX + (size_t)(row + rstep) * D + col); }
    }
#pragma unroll
    for (int i = 0; i < 4; ++i) {
      const int col = (i * 64 + lane) * 4;
      const float4 xv = cx[i];
      const uint2 mv = cm[i];
      const float4 g = *(const float4*)(p->g_post_mix + col);
      const float4 gt = *(const float4*)(gt1 + col);
      v[i].x = xv.x + gt.x * (bflo(mv.x) * rm * g.x);
      v[i].y = xv.y + gt.y * (bfhi(mv.x) * rm * g.y);
      v[i].z = xv.z + gt.z * (bflo(mv.y) * rm * g.z);
      v[i].w = xv.w + gt.w * (bfhi(mv.y) * rm * g.w);
      ss += v[i].x * v[i].x + v[i].y * v[i].y + v[i].z * v[i].z + v[i].w * v[i].w;
    }
    ss = wave_sum(ss);
    const float rstd = rsqrtf(ss * (1.f / 1024.f) + 1e-6f);
#pragma unroll
    for (int i = 0; i < 4; ++i) {
      const int col = (i * 64 + lane) * 4;
      const float4 g = *(const float4*)(p->g_pre_ffn + col);
      const float4 s1 = *(const float4*)(sc2 + col);
      const float4 s0 = *(const float4*)(sh2 + col);
      st4(H + (size_t)row * D + col, v[i].x * rstd * g.x * (1.f + s1.x) + s0.x, v[i].y * rstd * g.y * (1.f + s1.y) + s0.y,
          v[i].z * rstd * g.z * (1.f + s1.z) + s0.z, v[i].w * rstd * g.w * (1.f + s1.w) + s0.w);
    }
  }
}

DI void phase9(KP p, char* lds) {
  const int tid = otid(), lane = tid & 63, wave = tid >> 6;
  const int fr = lane & 15, fq = lane >> 4, wr = wave >> 2, wc = wave & 3;
  char* ws = ows(p);
  bf16_t* A = (bf16_t*)(ws + OFF_ACT);
  for (int k_ = 0;; ++k_) {
    int tn, tm; if (!tile_coord(k_, 22, tm, tn)) break;
    f32x4v acc[8][4];
    gemm_tile16((const bf16_t*)(ws + OFF_H) + (size_t)tm * 256 * 1024, 1024, (const bf16_t*)(ws + OFF_WFI) + (size_t)tn * 256 * 1024, 1024, 1024, acc, lds);
#pragma unroll
    for (int n = 0; n < 4; ++n) {
      const int tok = tm * 256 + wc * 64 + n * 16 + fr;
#pragma unroll
      for (int pm = 0; pm < 4; ++pm) {
        float o[4];
#pragma unroll
        for (int j = 0; j < 4; ++j) { const float gv = acc[2 * pm][n][j]; o[j] = gv * sigm(gv) * acc[2 * pm + 1][n][j]; }
        st4(A + (size_t)tok * 2816 + tn * 128 + wr * 64 + pm * 16 + 4 * fq, o[0], o[1], o[2], o[3]);
      }
    }
  }
}

DI void phase10(KP p) {
  const int tid_ = otid(); const int lane = tid_ & 63, wave = tid_ >> 6;
  char* wsl = ows(p);
  const float* ada = (const float*)(wsl + OFF_ADA);
  const bf16_t* F = (const bf16_t*)(wsl + OFF_F);
  const bf16_t* MX = (const bf16_t*)(wsl + OFF_MIXED);
  const float* ssf = (const float*)(wsl + OFF_SSF);
  const float* ssm = (const float*)(wsl + OFF_SSM);
  const int rstep = gridDim.x * NWAVE;
  float4 nx[4]; uint2 nm[4], nf[4];
  {
    const int row0 = blockIdx.x * NWAVE + wave;
    if (row0 < T) {
#pragma unroll
      for (int i = 0; i < 4; ++i) { const int col = (i * 64 + lane) * 4; nx[i] = *(const float4*)(p->x + (size_t)row0 * D + col);
        nm[i] = *(const uint2*)(MX + (size_t)row0 * D + col); nf[i] = *(const uint2*)(F + (size_t)row0 * D + col); }
    }
  }
  for (int row = blockIdx.x * NWAVE + wave; row < T; row += rstep) {
    const int b = row >> 12;
    const float rf = rsqrtf(ssf[row] * (1.f / 1024.f) + 1e-6f);
    const float rm = rsqrtf(ssm[row] * (1.f / 1024.f) + 1e-6f);
    const float* gt1 = ada + b * 6144 + 2048;
    const float* gt2 = ada + b * 6144 + 5120;
    float4 cx[4]; uint2 cm[4], cf[4];
#pragma unroll
    for (int i = 0; i < 4; ++i) { cx[i] = nx[i]; cm[i] = nm[i]; cf[i] = nf[i]; }
    if (row + rstep < T) {
#pragma unroll
      for (int i = 0; i < 4; ++i) { const int col = (i * 64 + lane) * 4; nx[i] = *(const float4*)(p->x + (size_t)(row + rstep) * D + col);
        nm[i] = *(const uint2*)(MX + (size_t)(row + rstep) * D + col); nf[i] = *(const uint2*)(F + (size_t)(row + rstep) * D + col); }
    }
#pragma unroll
    for (int i = 0; i < 4; ++i) {
      const int col = (i * 64 + lane) * 4;
      float4 xv = cx[i];
      const uint2 mv = cm[i];
      const uint2 fv = cf[i];
      const float4 g1 = *(const float4*)(p->g_post_mix + col);
      const float4 t1 = *(const float4*)(gt1 + col);
      const float4 g = *(const float4*)(p->g_post_ffn + col);
      const float4 gt = *(const float4*)(gt2 + col);
      xv.x = xv.x + t1.x * (bflo(mv.x) * rm * g1.x);
      xv.y = xv.y + t1.y * (bfhi(mv.x) * rm * g1.y);
      xv.z = xv.z + t1.z * (bflo(mv.y) * rm * g1.z);
      xv.w = xv.w + t1.w * (bfhi(mv.y) * rm * g1.w);
      xv.x += gt.x * (bflo(fv.x) * rf * g.x);
      xv.y += gt.y * (bfhi(fv.x) * rf * g.y);
      xv.z += gt.z * (bflo(fv.y) * rf * g.z);
      xv.w += gt.w * (bfhi(fv.y) * rf * g.w);
      *(float4*)(p->out + (size_t)row * D + col) = xv;
    }
  }
}

__global__ void __launch_bounds__(512, 2) fwd_kernel(Params pk) {
  __shared__ __attribute__((aligned(1024))) char lds[LDS_BYTES];
  const int pb = pk.phase_begin, pe = pk.phase_end;
  volatile LAS unsigned* st = (volatile LAS unsigned*)(lds + 135168);
  if (threadIdx.x == 0) { st[0] = 0u; st[1] = 0u; }
  __syncthreads();
  (void)xcd_barrier_post((unsigned*)(pk.ws + OFF_BAR), st);
  for (int ph = pb; ph < pe; ++ph) {
    KP p = get_kp();
    switch (ph) {
      case 0: phase0(p, lds); break;
      case 1: phase1(p); break;
      case 2: phase2(p, lds); break;
      case 3: phase3(p, lds); break;
      case 4: phase_carry(p); break;
      case 5: phase4(p, lds); break;
      case 6: phase5(p, lds); break;
      case 7: phase6(p, lds); break;
      case 8: phase_gemm_ss(p, lds, OFF_M, 1024, OFF_WMIX, OFF_MIXED, OFF_SSM); break;
      case 9: phase7(p); break;
      case 10: phase9(p, lds); break;
      case 11: phase_gemm_ss(p, lds, OFF_ACT, 2816, OFF_WFO, OFF_F, OFF_SSF); break;
      case 12: phase10(p); break;
    }
    if (ph + 1 < pe) {
      XcdBarrier b; b.bar = (unsigned*)(get_kp()->ws + OFF_BAR); b.x = xb_xcc_id(); b.st = (volatile LAS unsigned*)(lds + 135168);
      xcd_barrier(b);
    }
  }
}

extern "C" void kernel_launch(void* const* d_in, const int* in_sizes, int n_in, void* d_out, int out_size, void* d_ws, size_t ws_size, hipStream_t stream) {
  static int grid_blocks = 0;
  if (!grid_blocks) {
    int dev = 0, cus = 0, per_cu = 0;
    hipGetDevice(&dev);
    hipDeviceGetAttribute(&cus, hipDeviceAttributeMultiprocessorCount, dev);
    hipOccupancyMaxActiveBlocksPerMultiprocessor(&per_cu, fwd_kernel, NTHR, 0);
    if (per_cu > 1) per_cu = 1;
    if (per_cu < 1) per_cu = 1;
    grid_blocks = cus * per_cu;
  }
  Params p{};
  p.x = (const float*)d_in[0]; p.c = (const float*)d_in[1]; p.pos = (const int*)d_in[2]; p.w_ada = (const float*)d_in[3]; p.b_ada = (const float*)d_in[4];
  p.g_pre_mix = (const float*)d_in[5]; p.g_post_mix = (const float*)d_in[6]; p.g_pre_ffn = (const float*)d_in[7]; p.g_post_ffn = (const float*)d_in[8];
  p.w_in = (const float*)d_in[9]; p.g_q = (const float*)d_in[10]; p.g_kv = (const float*)d_in[11]; p.w_uq = (const float*)d_in[12]; p.w_uk = (const float*)d_in[13];
  p.w_uv = (const float*)d_in[14]; p.w_o = (const float*)d_in[15];
  p.lam_re = (const float*)d_in[16]; p.lam_im = (const float*)d_in[17]; p.log_dt = (const float*)d_in[18]; p.b_re = (const float*)d_in[19]; p.b_im = (const float*)d_in[20];
  p.c_re = (const float*)d_in[21]; p.c_im = (const float*)d_in[22]; p.ssm_d = (const float*)d_in[23];
  p.w_glu = (const float*)d_in[24]; p.w_mix = (const float*)d_in[25]; p.w_ffn_in = (const float*)d_in[26]; p.w_ffn_out = (const float*)d_in[27];
  p.out = (float*)d_out; p.ws = (char*)d_ws;
#if COOP
  hipMemsetAsync((char*)d_ws + OFF_BAR, 0, XCD_BAR_WORDS * 4, stream);
  p.phase_begin = 0; p.phase_end = NPHASE;
  void* args[] = {&p};
  hipError_t e = hipLaunchCooperativeKernel((void*)fwd_kernel, dim3(grid_blocks), dim3(NTHR), args, 0, stream);
  if (e != hipSuccess) fprintf(stderr, "cooperative launch failed: %s (grid %d)\n", hipGetErrorString(e), grid_blocks);
#else
  for (int ph = 0; ph < NPHASE; ++ph) {
    p.phase_begin = ph; p.phase_end = ph + 1;
    hipLaunchKernelGGL(fwd_kernel, dim3(grid_blocks), dim3(NTHR), 0, stream, p);
  }
#endif
}
```
